# Optimizing an MI355X kernel written in HIP

```python
import math
import jax, jax.numpy as jnp
from jax import lax
import numpy as np

D_MODEL = 1024
BATCH = 8
SEQ = 4096
DEPTH = 4

HEAD_DIM = 64
N_A_LAYERS = DEPTH // 2
N_B_LAYERS = DEPTH - N_A_LAYERS
MEM_LEN = 256
MEM_HEADS = 4
MEM_W = MEM_HEADS * HEAD_DIM
RWKV_HEADS = (D_MODEL - MEM_W) // HEAD_DIM
RWKV_W = RWKV_HEADS * HEAD_DIM
DECAY_LORA = 64
AAA_LORA = 64
GATE_LORA = 128
RWKV_SHIFT_W = 3 * RWKV_W + DECAY_LORA + AAA_LORA + GATE_LORA
A_IN_W = RWKV_SHIFT_W + MEM_W
DIL_GROUPS = ((128, 1), (512, 4), (2048, 16))
DIL_GROUP_HEADS = 4
DIL_HEADS = len(DIL_GROUPS) * DIL_GROUP_HEADS
DIL_W = DIL_HEADS * HEAD_DIM
DIL_OUT_W = DIL_GROUP_HEADS * HEAD_DIM
BLOCK = 128
NUM_BUCKETS = 32
MAX_DISTANCE = 2048
D_FF = 2816
NORM_EPS = 1e-6
LNX_EPS = 64e-5
NEG_INF = -1e30

kernel_name = 'yoco_rwkv7_dilated_macaron_hybrid'


def rms_norm(x, g):
    xf = x.astype(jnp.float32)
    y = xf * lax.rsqrt(jnp.mean(xf * xf, axis=-1, keepdims=True) + NORM_EPS)
    return (y * g.astype(jnp.float32)).astype(x.dtype)


def split_heads(t):
    return t.reshape(t.shape[:-1] + (t.shape[-1] // HEAD_DIM, HEAD_DIM))


def swiglu_ffn(x, norm_g, w_in, w_out):
    gate, up = jnp.split(rms_norm(x, norm_g) @ w_in, 2, axis=-1)
    return (jax.nn.silu(gate) * up) @ w_out


def token_shift(p, mu):
    prev = jnp.pad(p, ((0, 0), (1, 0), (0, 0)))[:, :-1]
    return p + mu * (prev - p)


def rwkv7_scan(r, w, k, v, kk, a):
    b, _, h, n = r.shape

    def step(state, inp):
        r_t, w_t, k_t, v_t, kk_t, a_t = inp
        sa = jnp.einsum('bhvk,bhk->bhv', state, -kk_t)
        state = (state * w_t[:, :, None, :]
                 + sa[..., None] * (kk_t * a_t)[:, :, None, :]
                 + v_t[..., None] * k_t[:, :, None, :])
        return state, jnp.einsum('bhvk,bhk->bhv', state, r_t)

    xs = tuple(jnp.moveaxis(t.astype(jnp.float32), 1, 0) for t in (r, w, k, v, kk, a))
    _, ys = lax.scan(step, jnp.zeros((b, h, n, n), jnp.float32), xs)
    return jnp.moveaxis(ys, 0, 1)


def rwkv7_mix(p, mu, w0, w_up, a0, a_up, g_up, kk_scale, k_a, r_k, lnx_g, lnx_b):
    out_dtype = p.dtype
    b, s = p.shape[:2]
    p = token_shift(p, mu).astype(jnp.float32)
    cuts = [RWKV_W, 2 * RWKV_W, 3 * RWKV_W, 3 * RWKV_W + DECAY_LORA,
            3 * RWKV_W + DECAY_LORA + AAA_LORA]
    r, k, v, w_lo, a_lo, g_lo = jnp.split(p, cuts, axis=-1)
    w_log = -jax.nn.softplus(-(w0 + jnp.tanh(w_lo) @ w_up)) - 0.5
    decay = jnp.exp(-jnp.exp(w_log))
    a = jax.nn.sigmoid(a0 + a_lo @ a_up)
    g = jax.nn.sigmoid(g_lo) @ g_up
    kk = split_heads(k * kk_scale)
    kk = kk / jnp.maximum(jnp.linalg.norm(kk, axis=-1, keepdims=True), 1e-12)
    k = k * (1.0 + (a - 1.0) * k_a)
    r_h, k_h, v_h, a_h, w_h = (split_heads(t) for t in (r, k, v, a, decay))
    y = rwkv7_scan(r_h, w_h, k_h, v_h, kk, a_h)
    mean = jnp.mean(y, axis=-1, keepdims=True)
    var = jnp.mean(jnp.square(y - mean), axis=-1, keepdims=True)
    y = ((y - mean) * lax.rsqrt(var + LNX_EPS)).reshape(b, s, RWKV_W) * lnx_g + lnx_b
    bonus = jnp.sum(r_h * k_h * r_k, axis=-1, keepdims=True) * v_h
    y = (y + bonus.reshape(b, s, RWKV_W)) * g
    return y.astype(out_dtype)


def memory_attention(q, mem, mem_norm_g, w_kv, q_gain, k_gain):
    k, v = jnp.split(rms_norm(mem, mem_norm_g) @ w_kv, 2, axis=-1)
    k = rms_norm(split_heads(k), k_gain)
    v = split_heads(v)
    q = rms_norm(q, q_gain)
    logits = jnp.einsum('bshd,bmhd->bhsm', q, k).astype(jnp.float32) / math.sqrt(HEAD_DIM)
    probs = jax.nn.softmax(logits, axis=-1)
    return jnp.einsum('bhsm,bmhd->bshd', probs.astype(v.dtype), v)


def padded_len(seq_len, dil):
    unit = dil * BLOCK
    return -(-seq_len // unit) * unit


def strided_blocks(t, dil, s_pad):
    b, s = t.shape[:2]
    t = jnp.pad(t, ((0, 0), (0, s_pad - s)) + ((0, 0),) * (t.ndim - 2))
    t = t.reshape((b, s_pad // dil, dil) + t.shape[2:])
    t = jnp.moveaxis(t, 2, 1)
    return t.reshape((b, dil, s_pad // (dil * BLOCK), BLOCK) + t.shape[3:])


def unstride_blocks(t, seq_len):
    b, dil, nb, blk = t.shape[:4]
    t = t.reshape((b, dil, nb * blk) + t.shape[4:])
    t = jnp.moveaxis(t, 1, 2)
    return t.reshape((b, dil * nb * blk) + t.shape[3:])[:, :seq_len]


def with_prev_block(t):
    prev = jnp.pad(t[:, :, :-1], ((0, 0), (0, 0), (1, 0), (0, 0), (0, 0), (0, 0)))
    return jnp.concatenate([prev, t], axis=3)


def t5_bucket(dist):
    max_exact = NUM_BUCKETS // 2
    d_f = jnp.maximum(dist, 1).astype(jnp.float32)
    large = max_exact + (jnp.log(d_f / max_exact) / math.log(MAX_DISTANCE / max_exact)
                         * (NUM_BUCKETS - max_exact)).astype(jnp.int32)
    large = jnp.minimum(large, NUM_BUCKETS - 1)
    return jnp.where(dist < max_exact, dist, large)


def band_mask_and_bias(window, dil, n_blocks, table):
    span = window // dil
    qi = jnp.arange(BLOCK)[:, None]
    kj = jnp.arange(2 * BLOCK)[None, :]
    dsub = BLOCK + qi - kj
    band = (dsub >= 0) & (dsub <= span)
    first = (jnp.arange(n_blocks)[:, None, None] > 0) | (kj[None] >= BLOCK)
    mask = band[None] & first
    bias = jnp.transpose(table[t5_bucket(jnp.maximum(dsub, 0) * dil)], (2, 0, 1))
    return mask, bias


def shared_kv_blocks(x, kv_norm, kv_w, k_gain):
    k, v = jnp.split(rms_norm(x, kv_norm) @ kv_w, 2, axis=-1)
    k = rms_norm(split_heads(k), k_gain)
    v = split_heads(v)
    seq_len = x.shape[1]
    k_blocks, v_blocks = [], []
    for g, (_, dil) in enumerate(DIL_GROUPS):
        hs = slice(g * DIL_GROUP_HEADS, (g + 1) * DIL_GROUP_HEADS)
        s_pad = padded_len(seq_len, dil)
        k_blocks.append(strided_blocks(k[:, :, hs], dil, s_pad))
        v_blocks.append(strided_blocks(v[:, :, hs], dil, s_pad))
    return k_blocks, v_blocks


def dilated_attention(q, k_blocks, v_blocks, q_gain, rel_bias, seq_len):
    q = rms_norm(q, q_gain)
    scale = 1.0 / math.sqrt(HEAD_DIM)
    outs, lses = [], []
    for g, (window, dil) in enumerate(DIL_GROUPS):
        hs = slice(g * DIL_GROUP_HEADS, (g + 1) * DIL_GROUP_HEADS)
        qb = strided_blocks(q[:, :, hs], dil, padded_len(seq_len, dil))
        kw = with_prev_block(k_blocks[g])
        vw = with_prev_block(v_blocks[g]).astype(jnp.float32)
        mask, bias = band_mask_and_bias(window, dil, qb.shape[2], rel_bias[:, hs])
        logits = jnp.einsum('brnqhd,brnkhd->brnhqk', qb, kw).astype(jnp.float32) * scale
        logits = jnp.where(mask[:, None], logits + bias, NEG_INF)
        m = jnp.max(logits, axis=-1, keepdims=True)
        p = jnp.exp(logits - m)
        l = jnp.sum(p, axis=-1, keepdims=True)
        o = jnp.einsum('brnhqk,brnkhd->brnqhd', p, vw) / jnp.swapaxes(l, 3, 4)
        lse = jnp.swapaxes(m + jnp.log(l), 3, 4)
        outs.append(unstride_blocks(o, seq_len))
        lses.append(unstride_blocks(lse, seq_len))
    weights = jax.nn.softmax(jnp.stack(lses), axis=0)
    return jnp.sum(weights * jnp.stack(outs), axis=0).astype(q.dtype)


def setup_inputs(seed: int = 0) -> dict:
    key = jax.random.key(seed)
    keys = iter(jax.random.split(key, 48))

    def normal(shape, scale):
        return jax.random.normal(next(keys), shape, jnp.float32) * scale

    def gain(shape):
        return 1.0 + normal(shape, 0.02)

    def uniform(shape, lo, hi):
        return jax.random.uniform(next(keys), shape, jnp.float32, lo, hi)

    d, f = D_MODEL, D_FF
    return {
        'x': normal((BATCH, SEQ, d), 1.0),
        'mem': normal((BATCH, MEM_LEN, d), 1.0),
        'ffn_pre_norm': gain((DEPTH, d)),
        'ffn_pre_w_in': normal((DEPTH, d, 2 * f), d ** -0.5),
        'ffn_pre_w_out': normal((DEPTH, f, d), f ** -0.5),
        'mix_norm': gain((DEPTH, d)),
        'ffn_post_norm': gain((DEPTH, d)),
        'ffn_post_w_in': normal((DEPTH, d, 2 * f), d ** -0.5),
        'ffn_post_w_out': normal((DEPTH, f, d), f ** -0.5),
        'mem_norm': gain((DEPTH, d)),
        'mem_w_kv': normal((DEPTH, d, 2 * MEM_W), d ** -0.5),
        'mem_q_norm': gain((DEPTH, HEAD_DIM)),
        'mem_k_norm': gain((DEPTH, HEAD_DIM)),
        'a_w_in': normal((N_A_LAYERS, d, A_IN_W), d ** -0.5),
        'a_shift_mu': uniform((N_A_LAYERS, RWKV_SHIFT_W), 0.0, 1.0),
        'a_w0': uniform((N_A_LAYERS, RWKV_W), -6.0, -1.0),
        'a_w_up': normal((N_A_LAYERS, DECAY_LORA, RWKV_W), 0.5 * DECAY_LORA ** -0.5),
        'a_a0': normal((N_A_LAYERS, RWKV_W), 0.1),
        'a_a_up': normal((N_A_LAYERS, AAA_LORA, RWKV_W), AAA_LORA ** -0.5),
        'a_g_up': normal((N_A_LAYERS, GATE_LORA, RWKV_W), GATE_LORA ** -0.5),
        'a_kk_scale': 0.85 + normal((N_A_LAYERS, RWKV_W), 0.02),
        'a_k_a': gain((N_A_LAYERS, RWKV_W)),
        'a_r_k': normal((N_A_LAYERS, RWKV_HEADS, HEAD_DIM), 0.1),
        'a_lnx_g': gain((N_A_LAYERS, RWKV_W)),
        'a_lnx_b': normal((N_A_LAYERS, RWKV_W), 0.01),
        'a_w_out': normal((N_A_LAYERS, RWKV_W + MEM_W, d), (RWKV_W + MEM_W) ** -0.5),
        'b_w_q': normal((N_B_LAYERS, d, DIL_W + MEM_W), d ** -0.5),
        'b_q_norm': gain((N_B_LAYERS, HEAD_DIM)),
        'b_w_out': normal((N_B_LAYERS, DIL_OUT_W + MEM_W, d), (DIL_OUT_W + MEM_W) ** -0.5),
        'kv_norm': gain((d,)),
        'kv_w': normal((d, 2 * DIL_W), d ** -0.5),
        'kv_k_norm': gain((HEAD_DIM,)),
        'rel_bias': normal((NUM_BUCKETS, DIL_HEADS), 0.2),
    }


def reference(x, mem, ffn_pre_norm, ffn_pre_w_in, ffn_pre_w_out, mix_norm,
              ffn_post_norm, ffn_post_w_in, ffn_post_w_out,
              mem_norm, mem_w_kv, mem_q_norm, mem_k_norm,
              a_w_in, a_shift_mu, a_w0, a_w_up, a_a0, a_a_up, a_g_up,
              a_kk_scale, a_k_a, a_r_k, a_lnx_g, a_lnx_b, a_w_out,
              b_w_q, b_q_norm, b_w_out, kv_norm, kv_w, kv_k_norm, rel_bias):
    b, s = x.shape[:2]
    k_blocks, v_blocks = None, None
    for layer in range(DEPTH):
        x = x + 0.5 * swiglu_ffn(x, ffn_pre_norm[layer], ffn_pre_w_in[layer], ffn_pre_w_out[layer])
        u = rms_norm(x, mix_norm[layer])
        if layer < N_A_LAYERS:
            i = layer
            proj = u @ a_w_in[i]
            y_main = rwkv7_mix(proj[..., :RWKV_SHIFT_W], a_shift_mu[i], a_w0[i], a_w_up[i],
                               a_a0[i], a_a_up[i], a_g_up[i], a_kk_scale[i], a_k_a[i],
                               a_r_k[i], a_lnx_g[i], a_lnx_b[i])
            y_mem = memory_attention(split_heads(proj[..., RWKV_SHIFT_W:]), mem, mem_norm[layer],
                                     mem_w_kv[layer], mem_q_norm[layer], mem_k_norm[layer])
            y = jnp.concatenate([y_main, y_mem.reshape(b, s, MEM_W)], axis=-1) @ a_w_out[i]
        else:
            j = layer - N_A_LAYERS
            q_all = u @ b_w_q[j]
            y_dil = dilated_attention(split_heads(q_all[..., :DIL_W]), k_blocks, v_blocks,
                                      b_q_norm[j], rel_bias, s)
            y_mem = memory_attention(split_heads(q_all[..., DIL_W:]), mem, mem_norm[layer],
                                     mem_w_kv[layer], mem_q_norm[layer], mem_k_norm[layer])
            y = jnp.concatenate([y_dil.reshape(b, s, DIL_OUT_W),
                                 y_mem.reshape(b, s, MEM_W)], axis=-1) @ b_w_out[j]
        x = x + y
        x = x + 0.5 * swiglu_ffn(x, ffn_post_norm[layer], ffn_post_w_in[layer], ffn_post_w_out[layer])
        if layer == N_A_LAYERS - 1:
            k_blocks, v_blocks = shared_kv_blocks(x, kv_norm, kv_w, kv_k_norm)
    return x
```

```cpp
#include <hip/hip_runtime.h>
#include <hip/hip_cooperative_groups.h>
#include <cstdio>
namespace cg = cooperative_groups;

#ifndef MK_SINGLE
#define MK_SINGLE 1
#endif

#define LAS __attribute__((address_space(3)))
typedef unsigned short bf16_t;
typedef short bf16x8 __attribute__((ext_vector_type(8)));
typedef short bf16x4 __attribute__((ext_vector_type(4)));
typedef float f32x4 __attribute__((ext_vector_type(4)));
typedef float f32x2 __attribute__((ext_vector_type(2)));
typedef unsigned u32x4 __attribute__((ext_vector_type(4)));
typedef unsigned u32x2 __attribute__((ext_vector_type(2)));
#define GAS __attribute__((address_space(1)))
typedef GAS float gfloat;
typedef GAS unsigned short gbf16;

constexpr int T = 32768, D = 1024, FF = 2816, SEQ = 4096;
constexpr int AIN = 2816, RW = 768, LORA_N = 2304, KVW = 1536;
constexpr float NORM_EPS = 1e-6f;
constexpr size_t MiB = 1u << 20;
constexpr size_t WS_SSQ = 0;
constexpr size_t WS_MEMSSQ = 3584 * 1024;
constexpr size_t WS_LSE = 2 * MiB;
constexpr size_t WS_BAR = 3840 * 1024;
constexpr size_t WS_MEMB = 4 * MiB;
constexpr size_t WS_MEMKV = 8 * MiB;
constexpr size_t WS_W = 16 * MiB;
constexpr size_t WS_XB = 60 * MiB;
constexpr size_t WS_H = 124 * MiB;
constexpr size_t WS_LORA = 300 * MiB;
constexpr size_t WS_CAT = 444 * MiB;
constexpr size_t WS_END = 508 * MiB;
constexpr size_t W_FIN_PRE = 0, W_FOUT_PRE = 11 * MiB, W_FIN_POST = 16 * MiB + 512 * 1024, W_FOUT_POST = 27 * MiB + 512 * 1024,
                 W_MIX_IN = 33 * MiB, W_MIX_OUT = 38 * MiB + 512 * 1024, W_LORA = 40 * MiB + 512 * 1024;
constexpr int LDS_BYTES = 147456, MISC_OFF = 147456 - 64;
#ifndef EXP_DELAY
#define EXP_DELAY 0
#endif
#ifndef DUPMASK
#define DUPMASK 0
#endif

__device__ __forceinline__ unsigned cvt_pk_bf16(float lo, float hi) { unsigned r; asm volatile("v_cvt_pk_bf16_f32 %0, %1, %2" : "=v"(r) : "v"(lo), "v"(hi)); return r; }
__device__ __forceinline__ float bflo(unsigned u) { return __uint_as_float(u << 16); }
__device__ __forceinline__ float bfhi(unsigned u) { return __uint_as_float(u & 0xffff0000u); }
__device__ __forceinline__ float bf1(bf16_t v) { return __uint_as_float((unsigned)v << 16); }
__device__ __forceinline__ float sigmoidf_(float x) { return __builtin_amdgcn_rcpf(1.0f + __expf(-x)); }
__device__ __forceinline__ float xsum_rows(float s) {
    const auto r = __builtin_amdgcn_permlane16_swap(__float_as_uint(s), __float_as_uint(s), false, false);
    s = __uint_as_float(r[0]) + __uint_as_float(r[1]);
    const auto q = __builtin_amdgcn_permlane32_swap(__float_as_uint(s), __float_as_uint(s), false, false);
    return __uint_as_float(q[0]) + __uint_as_float(q[1]);
}
template <int CTRL> __device__ __forceinline__ float dpp_f(float v) { return __int_as_float(__builtin_amdgcn_update_dpp(0, __float_as_int(v), CTRL, 0xf, 0xf, false)); }
__device__ __forceinline__ float allsum16(float v) {
    v += dpp_f<0x128>(v);
    v += dpp_f<0x124>(v);
    v += dpp_f<0x122>(v);
    v += dpp_f<0x121>(v);
    return v;
}

namespace pg8 {
constexpr int BM = 256, BK = 64, HALF = 128, HTB = HALF * BK * 2, STAGE_BYTES = 8 * HTB, NXCD = 8, WGM = 8;
__device__ __forceinline__ int lds_byte(int r, int c) { const int st = (r >> 4) * 2 + (c >> 5), rr = r & 15, cc = c & 31, ob = rr * 64 + cc * 2; return st * 1024 + (ob ^ (((ob >> 9) & 1) << 5)); }
__device__ __forceinline__ void stage_rc(int b, int& R, int& C) { const int st = b / 1024, sb = b % 1024, swz = sb ^ (((sb >> 9) & 1) << 5); R = (st >> 1) * 16 + swz / 64; C = (st & 1) * 32 + (swz % 64) / 2; }
__device__ __forceinline__ int perm32(int rho) { const int n = rho >> 4, i = rho & 15; return 8 * (i >> 2) + 4 * n + (i & 3); }
struct Unit { int pm, pn; };
struct Gemm { const bf16_t* A; const bf16_t* Bt; int M, N, K; };
struct StaticOrder {
    int nM, nN, nwg, G, c;
    __device__ void init(int M, int N, int G_, int c_) { nM = M / BM; nN = N / BM; nwg = nM * nN; G = G_; c = c_; }
    __device__ bool next(int i, Unit& u) const {
        const long L = (long)i * G + c; if (L >= nwg) return false;
        int wgid = (int)L; { const int q = nwg / NXCD, r = nwg % NXCD, xcd = wgid % NXCD, off = wgid / NXCD; wgid = (xcd < r ? xcd * (q + 1) : r * (q + 1) + (xcd - r) * q) + off; }
        const int nig = WGM * nN, gid = wgid / nig, fm = gid * WGM, gsz = (nM - fm) < WGM ? (nM - fm) : WGM;
        u.pm = fm + ((wgid % nig) % gsz); u.pn = (wgid % nig) / gsz; return true;
    }
};

struct Epi {
    int mode, perm;
    const gfloat* ssq_in; gbf16* ob; int ldo;
    gfloat* x;
    const gfloat* w0; const gfloat* a0;
    template <int NR> __device__ __forceinline__ void rstdN(float (&rs)[NR], int rowbase, int fq) const {
        const GAS f32x4* bp = (const GAS f32x4*)(ssq_in + (size_t)rowbase * 16 + 4 * fq);
        f32x4 p[NR];
#pragma unroll
        for (int m = 0; m < NR; ++m) p[m] = bp[m * 64];
        asm volatile("" :: "v"(bp));
#pragma unroll
        for (int m = 0; m < NR; ++m) {
            float s = (p[m][0] + p[m][1]) + (p[m][2] + p[m][3]);
            s = xsum_rows(s);
            rs[m] = rsqrtf(s * (1.0f / 1024.0f) + NORM_EPS);
        }
    }
    __device__ __forceinline__ void rstd8(float (&rs)[2][4], int row0, int fq) const {
        const GAS f32x4* b0 = (const GAS f32x4*)(ssq_in + (size_t)row0 * 16 + 4 * fq);
        const GAS f32x4* b1 = (const GAS f32x4*)(ssq_in + (size_t)(row0 + HALF) * 16 + 4 * fq);
        f32x4 p[2][4];
#pragma unroll
        for (int m = 0; m < 4; ++m) { p[0][m] = b0[m * 64]; p[1][m] = b1[m * 64]; }
        asm volatile("" :: "v"(b0), "v"(b1));
#pragma unroll
        for (int ai = 0; ai < 2; ++ai)
#pragma unroll
            for (int m = 0; m < 4; ++m) {
                float s = (p[ai][m][0] + p[ai][m][1]) + (p[ai][m][2] + p[ai][m][3]);
                s = xsum_rows(s);
                rs[ai][m] = rsqrtf(s * (1.0f / 1024.0f) + NORM_EPS);
            }
    }
    __device__ __forceinline__ float row_rstd(int row, int fq) const {
        const f32x4 p = *(const GAS f32x4*)(ssq_in + (size_t)row * 16 + 4 * fq);
        float s = (p[0] + p[1]) + (p[2] + p[3]);
        s += __shfl_xor(s, 16); s += __shfl_xor(s, 32);
        return rsqrtf(s * (1.0f / 1024.0f) + NORM_EPS);
    }
    template <int KIND> __device__ __forceinline__ void epi_bf16(const f32x4 (&acc)[2][2][4][2], const Unit& u, int row0, int wc, int fq) const {
        const int colt = u.pn * BM + wc * 32 + 8 * fq;
        const int seg = (KIND == 1) ? 0 : ((KIND == 2) ? 1 : 2);
        f32x4 bv[2][2];
        if (KIND == 1 || KIND == 2) {
            const GAS f32x4* bp = (const GAS f32x4*)((KIND == 1 ? w0 : a0) + (colt - seg * RW));
            bv[0][0] = bp[0]; bv[0][1] = bp[1]; bv[1][0] = bp[32]; bv[1][1] = bp[33];
            asm volatile("" :: "v"(bp));
        }
#pragma unroll
        for (int ai = 0; ai < 2; ++ai) {
            float rsv[4] = {1.0f, 1.0f, 1.0f, 1.0f};
            if (KIND == 0) rstdN<4>(rsv, row0 + ai * HALF, fq);
#pragma unroll
            for (int m = 0; m < 4; ++m) {
                const int row = row0 + ai * HALF + m * 16;
                const float rs = rsv[m];
#pragma unroll
                for (int bj = 0; bj < 2; ++bj) {
                    const int col = colt + bj * HALF;
                    float v[8];
#pragma unroll
                    for (int n = 0; n < 2; ++n)
#pragma unroll
                        for (int j = 0; j < 4; ++j) v[n * 4 + j] = acc[ai][bj][m][n][j] * rs;
                    if (KIND == 1) {
#pragma unroll
                        for (int e = 0; e < 8; ++e) v[e] = -0.60653066f * sigmoidf_(bv[bj][e >> 2][e & 3] + v[e]);
                    } else if (KIND == 2) {
#pragma unroll
                        for (int e = 0; e < 8; ++e) v[e] = sigmoidf_(bv[bj][e >> 2][e & 3] + v[e]);
                    }
                    u32x4 w; w.x = cvt_pk_bf16(v[0], v[1]); w.y = cvt_pk_bf16(v[2], v[3]); w.z = cvt_pk_bf16(v[4], v[5]); w.w = cvt_pk_bf16(v[6], v[7]);
                    *(GAS u32x4*)(ob + (size_t)row * ldo + col) = w;
                }
            }
        }
    }
    template <int AI, int M0> __device__ __forceinline__ void epi1_pair(const f32x4 (&acc)[2][2][4][2], int row0, int col0, int fq, const float scale, gfloat* ssq_out, int slot) const {
        const int rowa = row0 + AI * HALF + M0 * 16, rowb = rowa + 16;
        GAS f32x4* xa = (GAS f32x4*)(x + (size_t)rowa * D + col0); GAS f32x4* xb_ = (GAS f32x4*)(x + (size_t)rowb * D + col0);
        f32x4 va[2][2], vb[2][2];
#pragma unroll
        for (int bj = 0; bj < 2; ++bj)
#pragma unroll
            for (int n = 0; n < 2; ++n) { va[bj][n] = xa[bj * 32 + n * 4]; vb[bj][n] = xb_[bj * 32 + n * 4]; }
        asm volatile("" :: "v"(xa), "v"(xb_));
        GAS u32x2* oa = (GAS u32x2*)(ob + (size_t)rowa * D + col0); GAS u32x2* ob2 = (GAS u32x2*)(ob + (size_t)rowb * D + col0);
        float ssa = 0.f, ssb = 0.f;
#pragma unroll
        for (int bj = 0; bj < 2; ++bj)
#pragma unroll
            for (int n = 0; n < 2; ++n) {
                const f32x4 a = va[bj][n] + acc[AI][bj][M0][n] * scale, b = vb[bj][n] + acc[AI][bj][M0 + 1][n] * scale;
                xa[bj * 32 + n * 4] = a; xb_[bj * 32 + n * 4] = b;
                u32x2 wa; wa.x = cvt_pk_bf16(a[0], a[1]); wa.y = cvt_pk_bf16(a[2], a[3]); oa[bj * 32 + n * 4] = wa;
                u32x2 wb; wb.x = cvt_pk_bf16(b[0], b[1]); wb.y = cvt_pk_bf16(b[2], b[3]); ob2[bj * 32 + n * 4] = wb;
                ssa += (a[0] * a[0] + a[1] * a[1]) + (a[2] * a[2] + a[3] * a[3]);
                ssb += (b[0] * b[0] + b[1] * b[1]) + (b[2] * b[2] + b[3] * b[3]);
            }
        ssa = xsum_rows(ssa); ssb = xsum_rows(ssb);
        if (fq == 0) { ssq_out[(size_t)rowa * 16 + slot] = ssa; ssq_out[(size_t)rowb * 16 + slot] = ssb; }
    }
    __device__ __forceinline__ void operator()(const f32x4 (&acc)[2][2][4][2], const Unit& u, int wr, int wc, int fr, int fq, const float scale, gfloat* ssq_out) const {
        const int row0 = u.pm * BM + wr * 64 + fr;
        if (mode == 0) {
            const int col0 = u.pn * 128 + wc * 32 + 8 * fq;
#pragma unroll
            for (int ai = 0; ai < 2; ++ai) {
                float rsv[4];
                rstdN<4>(rsv, row0 + ai * HALF, fq);
#pragma unroll
                for (int m = 0; m < 4; ++m) {
                    const int row = row0 + ai * HALF + m * 16;
                    const float rs = rsv[m];
                    float hv[8];
#pragma unroll
                    for (int n = 0; n < 2; ++n)
#pragma unroll
                        for (int j = 0; j < 4; ++j) { const float g = acc[ai][0][m][n][j] * rs, up = acc[ai][1][m][n][j] * rs; hv[n * 4 + j] = g * up * __builtin_amdgcn_rcpf(1.0f + __expf(-g)); }
                    u32x4 w; w.x = cvt_pk_bf16(hv[0], hv[1]); w.y = cvt_pk_bf16(hv[2], hv[3]); w.z = cvt_pk_bf16(hv[4], hv[5]); w.w = cvt_pk_bf16(hv[6], hv[7]);
                    *(GAS u32x4*)(ob + (size_t)row * ldo + col0) = w;
                }
            }
        } else if (mode == 1) {
            const int col0 = u.pn * BM + wc * 32 + 4 * fq;
            epi1_pair<0, 0>(acc, row0, col0, fq, scale, ssq_out, u.pn * 4 + wc); epi1_pair<0, 2>(acc, row0, col0, fq, scale, ssq_out, u.pn * 4 + wc);
            epi1_pair<1, 0>(acc, row0, col0, fq, scale, ssq_out, u.pn * 4 + wc); epi1_pair<1, 2>(acc, row0, col0, fq, scale, ssq_out, u.pn * 4 + wc);
        } else {
            if (mode == 2) epi_bf16<0>(acc, u, row0, wc, fq);
            else if (mode == 5) epi_bf16<3>(acc, u, row0, wc, fq);
            else { const int seg = u.pn / 3; if (seg == 0) epi_bf16<1>(acc, u, row0, wc, fq); else if (seg == 1) epi_bf16<2>(acc, u, row0, wc, fq); else epi_bf16<3>(acc, u, row0, wc, fq); }
        }
    }
};

__device__ __forceinline__ void gemm_phase(LAS unsigned char* lds, const Gemm g, const StaticOrder& S, const Epi E, const float e_scale, gfloat* e_ssq_out, const int tid) {
    const int wid = __builtin_amdgcn_readfirstlane(tid >> 6), lane = tid & 63, wr = wid >> 2, wc = wid & 3, fr = lane & 15, fq = lane >> 4;
    const int K = g.K, nt = K / BK;
    unsigned voffA[2], voffB[2];
#pragma unroll
    for (int i = 0; i < 2; ++i) { int R, C; stage_rc(tid * 16 + i * 8192, R, C); const int Rb = E.perm ? ((R & ~31) + perm32(R & 31)) : R;
        voffA[i] = (unsigned)(R * K + C) * 2u; voffB[i] = (unsigned)(Rb * K + C) * 2u; }
    const size_t kstep = (size_t)(BK * 2);
    const size_t hstep = (size_t)HALF * K * 2;
    const size_t tstep = 2 * hstep;
    const unsigned ldsw = (unsigned)wid * 1024u;
    const int aoff = lds_byte(wr * 64 + fr, fq * 8), boff = lds_byte(wc * 32 + fr, fq * 8);
#define PG8_SA(b, h) (((b) * 2 + (h)) * HTB)
#define PG8_SB(b, h) ((4 + (b) * 2 + (h)) * HTB)
#define PG8_STAGE(bufoff, gbase, voff) do { _Pragma("unroll") for (int _i = 0; _i < 2; ++_i) \
        __builtin_amdgcn_global_load_lds((const unsigned*)((const char*)(gbase) + (voff)[_i]), (LAS unsigned*)(lds + (bufoff) + ldsw + _i * 8192), 16, 0, 0); } while (0)
#define PG8_LDA(dst, b, h) do { _Pragma("unroll") for (int m = 0; m < 4; ++m) _Pragma("unroll") for (int k = 0; k < 2; ++k) dst[m][k] = *(const LAS bf16x8*)(lds + PG8_SA(b, h) + aoff + m * 2048 + k * 1024); } while (0)
#define PG8_LDB(dst, b, h) do { _Pragma("unroll") for (int n = 0; n < 2; ++n) _Pragma("unroll") for (int k = 0; k < 2; ++k) dst[n][k] = *(const LAS bf16x8*)(lds + PG8_SB(b, h) + boff + n * 2048 + k * 1024); } while (0)
#define PG8_MMA(ai, bj, At, Bt) do { __builtin_amdgcn_s_setprio(1); _Pragma("unroll") for (int m = 0; m < 4; ++m) _Pragma("unroll") for (int n = 0; n < 2; ++n) _Pragma("unroll") for (int k = 0; k < 2; ++k) \
        acc[ai][bj][m][n] = __builtin_amdgcn_mfma_f32_16x16x32_bf16(Bt[n][k], At[m][k], acc[ai][bj][m][n], 0, 0, 0); __builtin_amdgcn_s_setprio(0); } while (0)
#define PG8_WAIT_V(n) asm volatile("s_waitcnt vmcnt(" #n ")" ::: "memory")
#define PG8_WAIT_L(n) asm volatile("s_waitcnt lgkmcnt(" #n ")" ::: "memory")
#define PG8_BAR __builtin_amdgcn_s_barrier()
#define PG8_SCHED __builtin_amdgcn_sched_barrier(0)
    Unit cur, nxt; int ui = 0;
    if (!S.next(0, cur)) return;
    f32x4 acc[2][2][4][2];
#pragma unroll
    for (int a = 0; a < 2; ++a)
#pragma unroll
        for (int b = 0; b < 2; ++b)
#pragma unroll
            for (int m = 0; m < 4; ++m)
#pragma unroll
                for (int n = 0; n < 2; ++n) acc[a][b][m][n] = (f32x4){0.f, 0.f, 0.f, 0.f};
    bf16x8 At[4][2], B0[2][2], B1[2][2];
    const char* cA = (const char*)g.A + (size_t)cur.pm * tstep; const char* cB = (const char*)g.Bt + (size_t)cur.pn * tstep;
    PG8_STAGE(PG8_SB(0, 0), cB, voffB); PG8_STAGE(PG8_SA(0, 0), cA, voffA); PG8_STAGE(PG8_SB(0, 1), cB + hstep, voffB); PG8_STAGE(PG8_SA(0, 1), cA + hstep, voffA);
    if (wr == 1) PG8_BAR;
    PG8_WAIT_V(4); PG8_BAR;
    PG8_STAGE(PG8_SB(1, 0), cB + kstep, voffB); PG8_STAGE(PG8_SA(1, 0), cA + kstep, voffA); PG8_STAGE(PG8_SB(1, 1), cB + hstep + kstep, voffB);
    PG8_WAIT_V(6); PG8_BAR;
    for (;;) {
        const bool has_next = S.next(ui + 1, nxt);
        const char* nA = has_next ? (const char*)g.A + (size_t)nxt.pm * tstep : cA; const char* nB = has_next ? (const char*)g.Bt + (size_t)nxt.pn * tstep : cB;
        for (int t = 0; t < nt; t += 2) {
            const bool last = (t == nt - 2);
            const char* a1 = cA + (size_t)(t + 1) * kstep;
            const char* a2 = last ? nA : cA + (size_t)(t + 2) * kstep; const char* b2 = last ? nB : cB + (size_t)(t + 2) * kstep;
            const char* a3 = a2 + kstep; const char* b3 = b2 + kstep;
            PG8_LDB(B0, 0, 0); PG8_SCHED; PG8_LDA(At, 0, 0); PG8_STAGE(PG8_SA(1, 1), a1 + hstep, voffA);
            PG8_WAIT_L(8); PG8_BAR; PG8_WAIT_L(0); PG8_MMA(0, 0, At, B0); PG8_BAR; PG8_SCHED;
            PG8_LDB(B1, 0, 1); PG8_STAGE(PG8_SB(0, 0), b2, voffB);
            PG8_BAR; PG8_WAIT_L(0); PG8_MMA(0, 1, At, B1); PG8_BAR;
            PG8_LDA(At, 0, 1); PG8_STAGE(PG8_SA(0, 0), a2, voffA);
            PG8_BAR; PG8_WAIT_L(0); PG8_MMA(1, 0, At, B0); PG8_BAR; PG8_SCHED;
            PG8_STAGE(PG8_SB(0, 1), b2 + hstep, voffB);
            PG8_WAIT_V(6); PG8_BAR; PG8_MMA(1, 1, At, B1); PG8_BAR;
            PG8_LDB(B0, 1, 0); PG8_SCHED; PG8_LDA(At, 1, 0); PG8_STAGE(PG8_SA(0, 1), a2 + hstep, voffA);
            PG8_WAIT_L(8); PG8_BAR; PG8_WAIT_L(0); PG8_MMA(0, 0, At, B0); PG8_BAR; PG8_SCHED;
            PG8_LDB(B1, 1, 1); PG8_STAGE(PG8_SB(1, 0), b3, voffB);
            PG8_BAR; PG8_WAIT_L(0); PG8_MMA(0, 1, At, B1); PG8_BAR;
            PG8_LDA(At, 1, 1); PG8_STAGE(PG8_SA(1, 0), a3, voffA);
            PG8_BAR; PG8_WAIT_L(0); PG8_MMA(1, 0, At, B0); PG8_BAR; PG8_SCHED;
            PG8_STAGE(PG8_SB(1, 1), b3 + hstep, voffB);
            PG8_WAIT_V(6); PG8_BAR; PG8_MMA(1, 1, At, B1); PG8_BAR;
        }
        E(acc, cur, wr, wc, fr, fq, e_scale, e_ssq_out);
#if EXP_DELAY
        if (E.mode == 0) { __builtin_amdgcn_s_sleep(100); __builtin_amdgcn_s_sleep(100); }
#endif
        if (!has_next) break;
#pragma unroll
        for (int a = 0; a < 2; ++a)
#pragma unroll
            for (int b = 0; b < 2; ++b)
#pragma unroll
                for (int m = 0; m < 4; ++m)
#pragma unroll
                    for (int n = 0; n < 2; ++n) acc[a][b][m][n] = (f32x4){0.f, 0.f, 0.f, 0.f};
        cur = nxt; cA = nA; cB = nB; ++ui;
    }
    PG8_WAIT_V(0);
    if (wr == 0) PG8_BAR;
    PG8_BAR;
#undef PG8_SA
#undef PG8_SB
#undef PG8_STAGE
#undef PG8_LDA
#undef PG8_LDB
#undef PG8_MMA
#undef PG8_WAIT_V
#undef PG8_WAIT_L
#undef PG8_BAR
#undef PG8_SCHED
}
}

struct Params { const float* in[33]; float* out; unsigned char* ws; int ph_lo, ph_hi; };

__device__ __forceinline__ void conv_T(const float* W, int K, int N, bf16_t* WT, const float* gain, int swi, int row_off, LAS float* scr, int gw, int NGW, int lane) {
    const int nblk = N / 32, nitems = (K / 64) * nblk;
    f32x4 tv[8];
    if (gw < nitems) {
        const int kb = gw / nblk, nb = gw % nblk;
        const float* wp = W + (size_t)(64 * kb + (lane >> 3)) * N + 32 * nb + 4 * (lane & 7);
#pragma unroll
        for (int i = 0; i < 8; ++i) tv[i] = *(const f32x4*)(wp + (size_t)(8 * i) * N);
    }
    for (int item = gw; item < nitems; item += NGW) {
        const int kb = item / nblk, nb = item % nblk, k0 = 64 * kb, n0 = 32 * nb;
#pragma unroll
        for (int i = 0; i < 8; ++i) { LAS float* d = scr + (8 * i + (lane >> 3)) * 33 + 4 * (lane & 7); d[0] = tv[i][0]; d[1] = tv[i][1]; d[2] = tv[i][2]; d[3] = tv[i][3]; }
        if (item + NGW < nitems) {
            const int it2 = item + NGW, kb2 = it2 / nblk, nb2 = it2 % nblk;
            const float* wp = W + (size_t)(64 * kb2 + (lane >> 3)) * N + 32 * nb2 + 4 * (lane & 7);
#pragma unroll
            for (int i = 0; i < 8; ++i) tv[i] = *(const f32x4*)(wp + (size_t)(8 * i) * N);
        }
        asm volatile("s_waitcnt lgkmcnt(0)" ::: "memory");
        int drow0;
        if (swi) { const int j0 = (n0 < FF) ? n0 : n0 - FF; drow0 = 256 * (j0 >> 7) + (j0 & 127) + ((n0 < FF) ? 0 : 128); } else drow0 = row_off + n0;
        const int c = lane & 7;
        float gv[8];
#pragma unroll
        for (int e = 0; e < 8; ++e) gv[e] = gain ? gain[k0 + 8 * c + e] : 1.0f;
#pragma unroll
        for (int j = 0; j < 4; ++j) { const int n = (lane >> 3) + 8 * j; const LAS float* s = scr + (8 * c) * 33 + n;
            u32x4 o; o.x = cvt_pk_bf16(s[0 * 33] * gv[0], s[1 * 33] * gv[1]); o.y = cvt_pk_bf16(s[2 * 33] * gv[2], s[3 * 33] * gv[3]);
            o.z = cvt_pk_bf16(s[4 * 33] * gv[4], s[5 * 33] * gv[5]); o.w = cvt_pk_bf16(s[6 * 33] * gv[6], s[7 * 33] * gv[7]);
            *(u32x4*)(WT + (size_t)(drow0 + n) * K + k0 + 8 * c) = o; }
        asm volatile("s_waitcnt lgkmcnt(0)" ::: "memory");
    }
}

constexpr int KS_PITCH = 72, VT_PITCH = 272;
constexpr int AT_KS = 0, AT_VT = 256 * KS_PITCH * 2, AT_RK = AT_VT + 64 * VT_PITCH * 2, AT_TB = AT_RK + 1024;
struct AttnIn { u32x4 k[4], v[4], q0, q1; };
__device__ __forceinline__ void attn_issue_kv(AttnIn& r, const bf16_t* Kp, const bf16_t* Vp, long kv_stride, bool clampk, const int tid) {
#pragma unroll
    for (int i = 0; i < 4; ++i) {
        { const int id = tid + 512 * i, key = id >> 3, ck = id & 7; const int krow = (clampk && key < 128) ? key + 128 : key;
          r.k[i] = *(const u32x4*)(Kp + (long)krow * kv_stride + ck * 8); }
        { const int id = tid + 512 * i, key = id & 255, ck = id >> 8; const int krow = (clampk && key < 128) ? key + 128 : key;
          r.v[i] = *(const u32x4*)(Vp + (long)krow * kv_stride + ck * 8); }
    }
}
__device__ __forceinline__ void attn_issue_q(AttnIn& r, const bf16_t* Qp, long q_stride, const int tid) {
    const int lane = tid & 63, w = tid >> 6, fr = lane & 15, fq = lane >> 4;
    const int qi = 16 * w + fr;
    r.q0 = *(const u32x4*)(Qp + (long)qi * q_stride + 8 * fq); r.q1 = *(const u32x4*)(Qp + (long)qi * q_stride + 32 + 8 * fq);
}
__device__ __forceinline__ void attn_issue(AttnIn& r, const bf16_t* Qp, long q_stride, const bf16_t* Kp, const bf16_t* Vp, long kv_stride, bool clampk, const int tid) {
    attn_issue_kv(r, Kp, Vp, kv_stride, clampk, tid); attn_issue_q(r, Qp, q_stride, tid);
}
template <int MODE> __device__ __forceinline__ void attn_run(LAS unsigned char* lds, AttnIn& r,
                                          int first, const float* qg1, const float* qg2, const float* rel_bias, int dil, int head,
                                          bf16_t* Op, long o_stride, float* lsep, long lse_stride, const int tid,
                                          bool has_next, const bf16_t* nQp, long nq_stride, const bf16_t* nKp, const bf16_t* nVp, long nkv_stride, bool nclamp) {
    const int lane = tid & 63, w = tid >> 6, fr = lane & 15, fq = lane >> 4;
    LAS bf16_t* Ks = (LAS bf16_t*)(lds + AT_KS); LAS bf16_t* Vt = (LAS bf16_t*)(lds + AT_VT);
    LAS float* rk = (LAS float*)(lds + AT_RK); LAS float* tb = (LAS float*)(lds + AT_TB);
    __syncthreads();
#pragma unroll
    for (int i = 0; i < 4; ++i) {
        { const int id = tid + 512 * i, key = id >> 3, ck = id & 7;
          const u32x4 kx = r.k[i];
          *(LAS u32x4*)(Ks + key * KS_PITCH + ck * 8) = kx;
          float ss = 0.f;
#pragma unroll
          for (int e = 0; e < 4; ++e) { const float a = bflo(kx[e]), b = bfhi(kx[e]); ss += a * a + b * b; }
          ss += __shfl_xor(ss, 1); ss += __shfl_xor(ss, 2); ss += __shfl_xor(ss, 4);
          if (ck == 0) rk[key] = rsqrtf(ss * (1.0f / 64.0f) + NORM_EPS); }
        { const int id = tid + 512 * i, key = id & 255, ck = id >> 8;
          const u32x4 vx = r.v[i];
#pragma unroll
          for (int e = 0; e < 4; ++e) { Vt[(ck * 8 + 2 * e) * VT_PITCH + key] = (bf16_t)(vx[e] & 0xffffu); Vt[(ck * 8 + 2 * e + 1) * VT_PITCH + key] = (bf16_t)(vx[e] >> 16); } }
    }
    if (MODE == 1 && tid < 129) {
        const int dist = tid * dil; int bucket;
        if (dist < 16) bucket = dist;
        else { const float v = logf((float)dist / 16.0f) / 4.852030263919617f * 16.0f; int lg = 16 + (int)v; bucket = lg < 31 ? lg : 31; }
        tb[tid] = rel_bias[bucket * 12 + head];
    }
    const int qi = 16 * w + fr;
    bf16x8 Qf0, Qf1; float rq;
    {
        const u32x4 q0 = r.q0, q1 = r.q1;
        float v0[8], v1[8]; float ss = 0.f;
#pragma unroll
        for (int e = 0; e < 4; ++e) { v0[2 * e] = bflo(q0[e]); v0[2 * e + 1] = bfhi(q0[e]); v1[2 * e] = bflo(q1[e]); v1[2 * e + 1] = bfhi(q1[e]); }
#pragma unroll
        for (int e = 0; e < 8; ++e) ss += v0[e] * v0[e] + v1[e] * v1[e];
        ss += __shfl_xor(ss, 16); ss += __shfl_xor(ss, 32);
        rq = rsqrtf(ss * (1.0f / 64.0f) + NORM_EPS) * 0.125f;
#pragma unroll
        for (int e = 0; e < 8; ++e) { v0[e] *= qg1[8 * fq + e] * qg2[8 * fq + e]; v1[e] *= qg1[32 + 8 * fq + e] * qg2[32 + 8 * fq + e]; }
        u32x4 a, b;
        a.x = cvt_pk_bf16(v0[0], v0[1]); a.y = cvt_pk_bf16(v0[2], v0[3]); a.z = cvt_pk_bf16(v0[4], v0[5]); a.w = cvt_pk_bf16(v0[6], v0[7]);
        b.x = cvt_pk_bf16(v1[0], v1[1]); b.y = cvt_pk_bf16(v1[2], v1[3]); b.z = cvt_pk_bf16(v1[4], v1[5]); b.w = cvt_pk_bf16(v1[6], v1[7]);
        Qf0 = __builtin_bit_cast(bf16x8, a); Qf1 = __builtin_bit_cast(bf16x8, b);
    }
    if (has_next) attn_issue_kv(r, nKp, nVp, nkv_stride, nclamp, tid);
    __syncthreads();
    constexpr int NB = (MODE == 1) ? 9 : 16, NS = (MODE == 1) ? 10 : 16;
    f32x4 s[NS];
#pragma unroll
    for (int i = 0; i < NB; ++i) {
        const int nb = (MODE == 1) ? (w + i) : i;
        const bf16x8 ka0 = *(const LAS bf16x8*)(Ks + (16 * nb + fr) * KS_PITCH + 8 * fq), ka1 = *(const LAS bf16x8*)(Ks + (16 * nb + fr) * KS_PITCH + 32 + 8 * fq);
        f32x4 z = (f32x4){0.f, 0.f, 0.f, 0.f};
        z = __builtin_amdgcn_mfma_f32_16x16x32_bf16(ka0, Qf0, z, 0, 0, 0);
        s[i] = __builtin_amdgcn_mfma_f32_16x16x32_bf16(ka1, Qf1, z, 0, 0, 0);
    }
    if (has_next) attn_issue_q(r, nQp, nq_stride, tid);
    if (MODE == 1) s[9] = (f32x4){0.f, 0.f, 0.f, 0.f};
    float mx = -3.0e38f;
#pragma unroll
    for (int i = 0; i < NB; ++i)
#pragma unroll
        for (int j = 0; j < 4; ++j) {
            const int key = 16 * ((MODE == 1) ? (w + i) : i) + 4 * fq + j;
            float lg = s[i][j] * rq * rk[key];
            if (MODE == 1) {
                const int dsub = 128 + qi - key;
                const bool valid = (dsub >= 0) && (dsub <= 128) && (first || key >= 128);
                const int di = dsub < 0 ? 0 : (dsub > 128 ? 128 : dsub);
                lg = valid ? lg + tb[di] : -1.0e30f;
            }
            s[i][j] = lg; mx = fmaxf(mx, lg);
        }
    mx = fmaxf(mx, __shfl_xor(mx, 16)); mx = fmaxf(mx, __shfl_xor(mx, 32));
    float l = 0.f;
#pragma unroll
    for (int i = 0; i < NB; ++i)
#pragma unroll
        for (int j = 0; j < 4; ++j) { const float p = __expf(s[i][j] - mx); s[i][j] = p; l += p; }
    l += __shfl_xor(l, 16); l += __shfl_xor(l, 32);
    f32x4 o[4];
#pragma unroll
    for (int nd = 0; nd < 4; ++nd) o[nd] = (f32x4){0.f, 0.f, 0.f, 0.f};
#pragma unroll
    for (int kb = 0; kb < NS / 2; ++kb) {
        u32x4 pa; pa.x = cvt_pk_bf16(s[2 * kb][0], s[2 * kb][1]); pa.y = cvt_pk_bf16(s[2 * kb][2], s[2 * kb][3]);
        pa.z = cvt_pk_bf16(s[2 * kb + 1][0], s[2 * kb + 1][1]); pa.w = cvt_pk_bf16(s[2 * kb + 1][2], s[2 * kb + 1][3]);
        const bf16x8 pf = __builtin_bit_cast(bf16x8, pa);
        int k0 = 32 * kb, k1 = 32 * kb + 16;
        if (MODE == 1) { k0 = 16 * (w + 2 * kb); const int b1 = w + 2 * kb + 1; k1 = 16 * (b1 > 15 ? 15 : b1); }
#pragma unroll
        for (int nd = 0; nd < 4; ++nd) {
            const LAS bf16_t* vp = Vt + (16 * nd + fr) * VT_PITCH + 4 * fq;
            const u32x2 v0 = *(const LAS u32x2*)(vp + k0), v1 = *(const LAS u32x2*)(vp + k1);
            u32x4 vb; vb.x = v0.x; vb.y = v0.y; vb.z = v1.x; vb.w = v1.y;
            o[nd] = __builtin_amdgcn_mfma_f32_16x16x32_bf16(pf, __builtin_bit_cast(bf16x8, vb), o[nd], 0, 0, 0);
        }
    }
    const float linv = 1.0f / l;
#pragma unroll
    for (int j = 0; j < 4; ++j) {
        const float li = __shfl(linv, 4 * fq + j);
        bf16_t* orow = Op + (long)(16 * w + 4 * fq + j) * o_stride;
#pragma unroll
        for (int nd = 0; nd < 4; ++nd) orow[16 * nd + fr] = (bf16_t)(cvt_pk_bf16(o[nd][j] * li, 0.f) & 0xffffu);
    }
    if (MODE == 1 && fq == 0) lsep[(long)qi * lse_stride] = mx + logf(l);
}
template <int MODE> __device__ __forceinline__ void attn_unit(LAS unsigned char* lds, const bf16_t* Qp, long q_stride, const bf16_t* Kp, const bf16_t* Vp, long kv_stride,
                                          int first, const float* qg1, const float* qg2, const float* rel_bias, int dil, int head,
                                          bf16_t* Op, long o_stride, float* lsep, long lse_stride, const int tid) {
    AttnIn r;
    attn_issue(r, Qp, q_stride, Kp, Vp, kv_stride, (MODE == 1) && !first, tid);
    attn_run<MODE>(lds, r, first, qg1, qg2, rel_bias, dil, head, Op, o_stride, lsep, lse_stride, tid, false, nullptr, 0, nullptr, nullptr, 0, false);
}
__device__ __forceinline__ void attn_decode_B(int u, int l, const bf16_t* qall, const bf16_t* kvb, const bf16_t* memkv,
                                              const bf16_t*& Qp, long& qs, const bf16_t*& Kp, const bf16_t*& Vp, long& kvs, bool& clampk) {
    if (u < 3072) {
        const int blk = u & 31, hh = (u >> 5) & 3, bg = u >> 7, g = bg % 3, b = bg / 3;
        const int dil = (g == 0) ? 1 : ((g == 1) ? 4 : 16), nper = 32 / dil, c = blk / nper, n = blk % nper, head = g * 4 + hh;
        const long tq0 = (long)b * SEQ + (long)(n * 128) * dil + c, tk0 = tq0 - 128L * dil;
        Qp = qall + tq0 * D + head * 64; qs = (long)dil * D; Kp = kvb + tk0 * KVW + head * 64; Vp = Kp + RW; kvs = (long)dil * KVW; clampk = (n == 0);
    } else {
        const int um = u - 3072, head = um & 3, tb = um >> 2; const long t0 = (long)tb * 128; const int b = (int)(t0 / SEQ);
        Qp = qall + t0 * D + RW + head * 64; qs = D; Kp = memkv + (size_t)(b * 256) * 2048 + l * 512 + head * 64; Vp = Kp + 256; kvs = 2048; clampk = false;
    }
}

constexpr int SC_TC = 32;
constexpr int SC_OPS = 0, SC_YB = 2 * SC_TC * 384 * 4, SC_CST = SC_YB + 16 * 512 * 4;
__device__ __forceinline__ void scan_fill(LAS float* opsd, const LAS float* cst, int ht, int tpos0, size_t tok0, int h, const bf16_t* proj, const bf16_t* lora) {
    const int htt = ht >> 4, hch = (ht & 15) * 4;
    const int tpos = tpos0 + htt; const size_t t_ = tok0 + tpos; const bool hp = tpos > 0;
    const bf16_t* p_ = proj + t_ * AIN + h * 64 + hch; const bf16_t* pq_ = p_ - (hp ? AIN : 0); const unsigned mk_ = hp ? 0xffffffffu : 0u;
    const u32x2 r_t = *(const u32x2*)p_, k_t = *(const u32x2*)(p_ + RW), v_t = *(const u32x2*)(p_ + 2 * RW);
    const u32x2 r_p = *(const u32x2*)pq_ & mk_, k_p = *(const u32x2*)(pq_ + RW) & mk_, v_p = *(const u32x2*)(pq_ + 2 * RW) & mk_;
    const bf16_t* l_ = lora + t_ * LORA_N + h * 64 + hch;
    const u32x2 pw = *(const u32x2*)l_, pa = *(const u32x2*)(l_ + RW);
    const f32x4 mur = *(const LAS f32x4*)(cst + hch), muk = *(const LAS f32x4*)(cst + 64 + hch), muv = *(const LAS f32x4*)(cst + 128 + hch),
                kks = *(const LAS f32x4*)(cst + 192 + hch), kav = *(const LAS f32x4*)(cst + 256 + hch);
    f32x4 rs, ks, vs, wv, av, kr; float ss = 0.f;
#pragma unroll
    for (int e = 0; e < 4; ++e) {
        const unsigned sh = e >> 1; const bool hi = e & 1;
        const float rt = hi ? bfhi(r_t[sh]) : bflo(r_t[sh]), rp = hi ? bfhi(r_p[sh]) : bflo(r_p[sh]);
        const float kt = hi ? bfhi(k_t[sh]) : bflo(k_t[sh]), kp = hi ? bfhi(k_p[sh]) : bflo(k_p[sh]);
        const float vt = hi ? bfhi(v_t[sh]) : bflo(v_t[sh]), vp = hi ? bfhi(v_p[sh]) : bflo(v_p[sh]);
        rs[e] = rt + mur[e] * (rp - rt); ks[e] = kt + muk[e] * (kp - kt); vs[e] = vt + muv[e] * (vp - vt);
        wv[e] = __expf(hi ? bfhi(pw[sh]) : bflo(pw[sh])); av[e] = hi ? bfhi(pa[sh]) : bflo(pa[sh]);
        kr[e] = ks[e] * kks[e]; ss += kr[e] * kr[e];
    }
    ss = allsum16(ss);
    const float inv = 1.0f / fmaxf(sqrtf(ss), 1e-12f);
    LAS float* o = opsd + htt * 384 + hch;
    f32x4 t0;
    *(LAS f32x4*)(o) = wv;
    t0 = kr * (-inv); *(LAS f32x4*)(o + 64) = t0;
    t0 = kr * inv * av; *(LAS f32x4*)(o + 128) = t0;
#pragma unroll
    for (int e = 0; e < 4; ++e) t0[e] = ks[e] * (1.0f + (av[e] - 1.0f) * kav[e]);
    *(LAS f32x4*)(o + 192) = t0;
    *(LAS f32x4*)(o + 256) = rs;
    *(LAS f32x4*)(o + 320) = vs;
}
__device__ __forceinline__ void scan_task(LAS unsigned char* lds, int b, int h, int half, const bf16_t* proj, const bf16_t* lora, bf16_t* yout,
                                          const float* mu, const float* kk_scale, const float* k_a, const int tid) {
    const int lane = tid & 63, w = tid >> 6;
    LAS float* ops = (LAS float*)(lds + SC_OPS); LAS float* ypart = (LAS float*)(lds + SC_YB); LAS float* cst = (LAS float*)(lds + SC_CST);
    __syncthreads();
    if (tid < 64) { cst[tid] = mu[h * 64 + tid]; cst[64 + tid] = mu[RW + h * 64 + tid]; cst[128 + tid] = mu[2 * RW + h * 64 + tid];
                    cst[192 + tid] = kk_scale[h * 64 + tid]; cst[256 + tid] = k_a[h * 64 + tid]; }
    const size_t tok0 = (size_t)b * SEQ;
    const int ht = tid - 256;
    __syncthreads();
    if (w >= 4) { scan_fill(ops, cst, ht, 0, tok0, h, proj, lora); scan_fill(ops + 16 * 384, cst, ht, 16, tok0, h, proj, lora); }
    const int kg = lane & 15, rA = (w & 3) * 8 + (lane >> 4), rB = rA + 4;
    const int vrowA = half * 32 + rA, vrowB = half * 32 + rB;
    f32x4 S = (f32x4){0.f, 0.f, 0.f, 0.f}, S2 = (f32x4){0.f, 0.f, 0.f, 0.f};
    __syncthreads();
    for (int c = 0; c < SEQ / SC_TC; ++c) {
        LAS float* opsb = ops + (c & 1) * (SC_TC * 384);
        LAS float* opsn = ops + ((c & 1) ^ 1) * (SC_TC * 384);
        for (int sub = 0; sub < 2; ++sub) {
            if (w < 4) {
                const LAS float* ob = opsb + (sub * 16) * 384 + kg * 4;
                const LAS float* vb = opsb + (sub * 16) * 384 + 320;
                f32x4 cw = *(const LAS f32x4*)(ob), cn = *(const LAS f32x4*)(ob + 64), cb = *(const LAS f32x4*)(ob + 128), ck = *(const LAS f32x4*)(ob + 192), cr = *(const LAS f32x4*)(ob + 256);
                float cvA = vb[vrowA], cvB = vb[vrowB];
                __builtin_amdgcn_s_setprio(3);
#pragma unroll 4
                for (int t16 = 0; t16 < 16; ++t16) {
                    const int tn = (t16 + 1) & 15;
                    const LAS float* nb_ = ob + tn * 384;
                    const f32x4 nw = *(const LAS f32x4*)(nb_), nn = *(const LAS f32x4*)(nb_ + 64), nb = *(const LAS f32x4*)(nb_ + 128), nk = *(const LAS f32x4*)(nb_ + 192), nr = *(const LAS f32x4*)(nb_ + 256);
                    const float nvA = vb[tn * 384 + vrowA], nvB = vb[tn * 384 + vrowB];
                    asm volatile("" ::: "memory");
                    f32x2 ta = S.lo * cn.lo; ta = S.hi * cn.hi + ta;
                    f32x2 tb = S2.lo * cn.lo; tb = S2.hi * cn.hi + tb;
                    float sa = ta.x + ta.y, sb = tb.x + tb.y;
                    sa = allsum16(sa); sb = allsum16(sb);
                    S = S * cw + (cb * sa + ck * cvA);
                    S2 = S2 * cw + (cb * sb + ck * cvB);
                    f32x2 ua = S.lo * cr.lo; ua = S.hi * cr.hi + ua;
                    f32x2 ub = S2.lo * cr.lo; ub = S2.hi * cr.hi + ub;
                    ypart[t16 * 512 + rA * 16 + kg] = ua.x + ua.y;
                    ypart[t16 * 512 + rB * 16 + kg] = ub.x + ub.y;
                    cw = nw; cn = nn; cb = nb; ck = nk; cr = nr; cvA = nvA; cvB = nvB;
                }
                __builtin_amdgcn_s_setprio(0);
            } else if (c + 1 < SEQ / SC_TC) {
                scan_fill(opsn + (sub * 16) * 384, cst, ht, (c + 1) * SC_TC + sub * 16, tok0, h, proj, lora);
            }
            __syncthreads();
            {
                const LAS float* yp_ = ypart + tid * 16;
                const f32x4 a = *(const LAS f32x4*)(yp_), b2 = *(const LAS f32x4*)(yp_ + 4), c2 = *(const LAS f32x4*)(yp_ + 8), d2 = *(const LAS f32x4*)(yp_ + 12);
                const float y = (((a[0] + a[1]) + (a[2] + a[3])) + ((b2[0] + b2[1]) + (b2[2] + b2[3]))) + (((c2[0] + c2[1]) + (c2[2] + c2[3])) + ((d2[0] + d2[1]) + (d2[2] + d2[3])));
                yout[(tok0 + c * SC_TC + sub * 16 + (tid >> 5)) * RW + h * 64 + half * 32 + (tid & 31)] = (bf16_t)(cvt_pk_bf16(y, 0.f) & 0xffffu);
            }
            __syncthreads();
        }
    }
}


__device__ __forceinline__ void conv_group(const __attribute__((address_space(4))) Params* PP, unsigned char* wreg, int l, int bits,
                                           LAS float* scr, int gw, int NGW, long gtid, long NGT, int lane) {
    const bool isA = l < 2; const int li = isA ? l : l - 2;
    if (bits & 1) {
        conv_T(PP->in[3] + (size_t)l * D * 2 * FF, D, 2 * FF, (bf16_t*)(wreg + W_FIN_PRE), PP->in[2] + l * D, 1, 0, scr, gw, NGW, lane);
        conv_T(PP->in[4] + (size_t)l * FF * D, FF, D, (bf16_t*)(wreg + W_FOUT_PRE), nullptr, 0, 0, scr, gw, NGW, lane);
    }
    if (bits & 2) {
        conv_T(PP->in[7] + (size_t)l * D * 2 * FF, D, 2 * FF, (bf16_t*)(wreg + W_FIN_POST), PP->in[6] + l * D, 1, 0, scr, gw, NGW, lane);
        conv_T(PP->in[8] + (size_t)l * FF * D, FF, D, (bf16_t*)(wreg + W_FOUT_POST), nullptr, 0, 0, scr, gw, NGW, lane);
    }
    if (bits & 4) {
        if (isA) conv_T(PP->in[13] + (size_t)li * D * AIN, D, AIN, (bf16_t*)(wreg + W_MIX_IN), PP->in[5] + l * D, 0, 0, scr, gw, NGW, lane);
        else conv_T(PP->in[26] + (size_t)li * D * D, D, D, (bf16_t*)(wreg + W_MIX_IN), PP->in[5] + l * D, 0, 0, scr, gw, NGW, lane);
    }
    if (bits & 8) {
        if (isA) conv_T(PP->in[25] + (size_t)li * D * D, D, D, (bf16_t*)(wreg + W_MIX_OUT), nullptr, 0, 0, scr, gw, NGW, lane);
        else conv_T(PP->in[28] + (size_t)li * 512 * D, 512, D, (bf16_t*)(wreg + W_MIX_OUT), nullptr, 0, 0, scr, gw, NGW, lane);
    }
    if ((bits & 16) && isA) {
        bf16_t* wl = (bf16_t*)(wreg + W_LORA);
        const float* wup = PP->in[16] + (size_t)li * 64 * RW; const float* aup = PP->in[18] + (size_t)li * 64 * RW; const float* gup = PP->in[19] + (size_t)li * 128 * RW;
        for (long i = gtid; i < (long)LORA_N * 256; i += NGT) {
            const int c = (int)(i >> 8), k = (int)(i & 255), seg = c / RW, cc = c - seg * RW; float v = 0.f;
            if (seg == 0) { if (k < 64) v = wup[k * RW + cc]; }
            else if (seg == 1) { if (k >= 64 && k < 128) v = aup[(k - 64) * RW + cc]; }
            else { if (k >= 128) v = gup[(k - 128) * RW + cc]; }
            wl[i] = (bf16_t)(cvt_pk_bf16(v, 0.f) & 0xffffu);
        }
    }
}

#define XB_TMO      128
#define XB_XCNT(j)  (256  + 64 * (j))
#define XB_XSUB(j)  (1280 + 64 * (j))
#define XB_XGEN(j)  (2304 + 64 * (j))
#define XB_TOP      3328
#define XB_TOPGEN   3392
#define XCD_BAR_WORDS 3456
#define XB_SPIN_CAP (1u << 18)
__device__ __forceinline__ unsigned xb_ld(unsigned* p)              { return __hip_atomic_load(p, __ATOMIC_RELAXED, __HIP_MEMORY_SCOPE_AGENT); }
__device__ __forceinline__ unsigned xb_add(unsigned* p, unsigned v) { return __hip_atomic_fetch_add(p, v, __ATOMIC_RELAXED, __HIP_MEMORY_SCOPE_AGENT); }
__device__ __forceinline__ unsigned xb_xcc_id() { return (unsigned)__builtin_amdgcn_s_getreg((3 << 11) | 20) & 0xFu; }
#define XB_SPIN(cond, bar) do { unsigned _sp = 0; while (cond) { __builtin_amdgcn_s_sleep(1); \
    if ((++_sp & 255u) == 0u) { if (xb_ld(&(bar)[XB_TMO])) break; if (_sp > XB_SPIN_CAP) { atomicAdd(&(bar)[XB_TMO], 1u); break; } } } } while (0)
struct XcdBarrier { unsigned* bar; unsigned x; volatile LAS unsigned* st; };
__device__ __forceinline__ XcdBarrier xcd_barrier_post(unsigned* bar, volatile LAS unsigned* st, const int tid) {
    XcdBarrier b; b.bar = bar; b.x = xb_xcc_id(); b.st = st;
    if (tid == 0) (void)xb_add(&bar[XB_XCNT(b.x)], 1u);
    return b;
}
__device__ __forceinline__ void xcd_barrier_complete(unsigned* bar, unsigned x, unsigned& nloc, unsigned& nx) {
    const unsigned G = gridDim.x * gridDim.y * gridDim.z;
    unsigned sum, cnt, mine, sp = 0u;
    for (;;) {
        sum = 0u; cnt = 0u; mine = 0u;
#pragma unroll
        for (unsigned j = 0; j < 16; ++j) { const unsigned c = xb_ld(&bar[XB_XCNT(j)]); sum += c; cnt += (c > 0u) ? 1u : 0u; mine = (j == x) ? c : mine; }
        if (sum == G) break;
        __builtin_amdgcn_s_sleep(1);
        if ((++sp & 255u) == 0u) { if (xb_ld(&bar[XB_TMO])) break; if (sp > XB_SPIN_CAP) { atomicAdd(&bar[XB_TMO], 1u); break; } }
    }
    nloc = mine > 0u ? mine : 1u; nx = cnt > 0u ? cnt : 1u;
}
__device__ __forceinline__ void xcd_barrier(const XcdBarrier& b, const int tid) {
    asm volatile("s_waitcnt vmcnt(0)" ::: "memory");
    __syncthreads();
    if (tid == 0) {
        unsigned* bar = b.bar;
        __builtin_amdgcn_s_waitcnt(0);
        unsigned nloc = b.st[0], nx = b.st[1];
        if (nloc == 0u) { xcd_barrier_complete(bar, b.x, nloc, nx); b.st[0] = nloc; b.st[1] = nx; }
        const unsigned old = xb_add(&bar[XB_XSUB(b.x)], 1u);
        const unsigned gen = old / nloc;
        if (old + 1u == (gen + 1u) * nloc) {
            __builtin_amdgcn_fence(__ATOMIC_RELEASE, "agent");
            asm volatile("s_waitcnt vmcnt(0)" ::: "memory");
            const unsigned og = xb_add(&bar[XB_TOP], 1u);
            const unsigned tg = og / nx;
            if (og + 1u == (tg + 1u) * nx) xb_add(&bar[XB_TOPGEN], 1u);
            else XB_SPIN(xb_ld(&bar[XB_TOPGEN]) == tg, bar);
            __builtin_amdgcn_fence(__ATOMIC_ACQUIRE, "agent");
            xb_add(&bar[XB_XGEN(b.x)], 1u);
            asm volatile("s_waitcnt vmcnt(0)" ::: "memory");
        } else {
            XB_SPIN(xb_ld(&bar[XB_XGEN(b.x)]) == gen, bar);
            __builtin_amdgcn_fence(__ATOMIC_ACQUIRE, "agent");
            asm volatile("s_waitcnt vmcnt(0)" ::: "memory");
        }
    }
    __syncthreads();
}

__global__ void __launch_bounds__(512, 2) fwd_kernel(Params P) {
    extern __shared__ __attribute__((aligned(16))) unsigned char lds_raw[];
    LAS unsigned char* lds = (LAS unsigned char*)lds_raw;
#if MK_SINGLE
    volatile LAS unsigned* misc = (volatile LAS unsigned*)(lds + MISC_OFF);
    if (threadIdx.x < 2) misc[threadIdx.x] = 0u;
    __syncthreads();
    (void)xcd_barrier_post((unsigned*)(P.ws + WS_BAR), misc, (int)threadIdx.x);
#endif
    const int wave_s = __builtin_amdgcn_readfirstlane((int)threadIdx.x >> 6);
    for (int it = P.ph_lo * 2; it < P.ph_hi * 2; ++it) {
        const int ph = it >> 1;
        if ((it & 1) && !((DUPMASK >> (ph % 12)) & 1)) continue;
        int tid = (wave_s << 6) | (int)__builtin_amdgcn_mbcnt_hi(~0u, __builtin_amdgcn_mbcnt_lo(~0u, 0u)); asm volatile("" : "+v"(tid));
        int bx = blockIdx.x; asm volatile("" : "+s"(bx));
        int G = gridDim.x; asm volatile("" : "+s"(G));
        const __attribute__((address_space(4))) Params* PP = (const __attribute__((address_space(4))) Params*)__builtin_amdgcn_kernarg_segment_ptr(); asm volatile("" : "+s"(PP));
        unsigned char* ws = PP->ws; float* X = PP->out;
#define lane (tid & 63)
#define wave (tid >> 6)
#define gw (bx * 8 + (tid >> 6))
#define NGW (G * 8)
#define gtid ((long)bx * 512 + tid)
#define NGT ((long)G * 512)
        float* ssq = (float*)(ws + WS_SSQ); float* memssq = (float*)(ws + WS_MEMSSQ); float* lse = (float*)(ws + WS_LSE);
        bf16_t* memb = (bf16_t*)(ws + WS_MEMB); bf16_t* memkv = (bf16_t*)(ws + WS_MEMKV);
        bf16_t* xb = (bf16_t*)(ws + WS_XB); bf16_t* yscan = xb; bf16_t* aprep = (bf16_t*)(ws + WS_XB + 48 * MiB);
        bf16_t* hbuf = (bf16_t*)(ws + WS_H); bf16_t* proj = hbuf; bf16_t* qall = hbuf; bf16_t* catb = (bf16_t*)(ws + WS_H + 64 * MiB);
        bf16_t* lora = (bf16_t*)(ws + WS_LORA); bf16_t* kvb = lora; bf16_t* og = (bf16_t*)(ws + WS_LORA + 96 * MiB); bf16_t* wmemkv = lora;
        bf16_t* cat = (bf16_t*)(ws + WS_CAT);
        unsigned char* wreg = ws + WS_W;
#define scr ((LAS float*)(lds + (tid >> 6) * 16384))
        const int l = ph / 12, p = ph % 12;
        const bool isA = l < 2; const int li = isA ? l : l - 2;
        const bool empty = (!isA && (p == 6 || p == 7)) || (p == 11 && l != 1) || (p == 0 && l != 0);
        if (empty) continue;
        if (p == 0) {
            if (l == 0) {
                for (int m = gw; m < T; m += NGW) {
                    const f32x4* xr = (const f32x4*)(PP->in[0] + (size_t)m * D) + lane; float s = 0.f;
#pragma unroll
                    for (int j = 0; j < 4; ++j) { const f32x4 v = xr[64 * j]; s += (v[0] * v[0] + v[1] * v[1]) + (v[2] * v[2] + v[3] * v[3]);
                        *((f32x4*)(X + (size_t)m * D) + lane + 64 * j) = v;
                        u32x2 o; o.x = cvt_pk_bf16(v[0], v[1]); o.y = cvt_pk_bf16(v[2], v[3]); *((u32x2*)(xb + (size_t)m * D) + lane + 64 * j) = o; }
#pragma unroll
                    for (int o = 1; o < 64; o <<= 1) s += __shfl_xor(s, o);
                    if (lane < 16) ssq[(size_t)m * 16 + lane] = (lane == 0) ? s : 0.f;
                }
                for (int m = gw; m < 2048; m += NGW) {
                    const f32x4* xr = (const f32x4*)(PP->in[1] + (size_t)m * D) + lane; float s = 0.f;
#pragma unroll
                    for (int j = 0; j < 4; ++j) { const f32x4 v = xr[64 * j]; s += (v[0] * v[0] + v[1] * v[1]) + (v[2] * v[2] + v[3] * v[3]);
                        u32x2 o; o.x = cvt_pk_bf16(v[0], v[1]); o.y = cvt_pk_bf16(v[2], v[3]); *((u32x2*)(memb + (size_t)m * D) + lane + 64 * j) = o; }
#pragma unroll
                    for (int o = 1; o < 64; o <<= 1) s += __shfl_xor(s, o);
                    if (lane < 16) memssq[(size_t)m * 16 + lane] = (lane == 0) ? s : 0.f;
                }
                for (int q = 0; q < 4; ++q)
                    conv_T(PP->in[10] + (size_t)q * D * 512, D, 512, wmemkv, PP->in[9] + q * D, 0, q * 512, scr, gw, NGW, lane);
            }
            conv_group(PP, wreg, 0, 1 | 4 | 8 | 16, scr, gw, NGW, gtid, NGT, lane);
        } else if (p == 1 || p == 2 || p == 3 || p == 5 || p == 8 || p == 9 || p == 10 || p == 11) {
            if (p == 5 && !isA) {
                if (l == 2) { conv_group(PP, wreg, 2, 2, scr, gw, NGW, gtid, NGT, lane);
                              conv_group(PP, wreg, 3, 1 | 4, scr, gw, NGW, gtid, NGT, lane); }
                if (l == 3) conv_group(PP, wreg, 3, 2, scr, gw, NGW, gtid, NGT, lane);
                for (long i0 = gtid; i0 < (long)T * 64; i0 += 4 * NGT) {
                    float l0[4], l1[4], l2[4]; u32x2 a[4], b[4], c[4];
#pragma unroll
                    for (int u = 0; u < 4; ++u) { const long i = i0 + u * NGT; const long t = i >> 6; const int hh = (int)(i >> 4) & 3, d = ((int)i & 15) * 4;
                        l0[u] = lse[t * 12 + hh]; l1[u] = lse[t * 12 + 4 + hh]; l2[u] = lse[t * 12 + 8 + hh];
                        a[u] = *(const u32x2*)(og + t * RW + hh * 64 + d); b[u] = *(const u32x2*)(og + t * RW + (4 + hh) * 64 + d); c[u] = *(const u32x2*)(og + t * RW + (8 + hh) * 64 + d); }
#pragma unroll
                    for (int u = 0; u < 4; ++u) { const long i = i0 + u * NGT; const long t = i >> 6; const int hh = (int)(i >> 4) & 3, d = ((int)i & 15) * 4;
                        const float mx = fmaxf(l0[u], fmaxf(l1[u], l2[u])); float w0 = __expf(l0[u] - mx), w1 = __expf(l1[u] - mx), w2 = __expf(l2[u] - mx);
                        const float inv = 1.0f / (w0 + w1 + w2); w0 *= inv; w1 *= inv; w2 *= inv;
                        u32x2 o; o.x = cvt_pk_bf16(w0 * bflo(a[u].x) + w1 * bflo(b[u].x) + w2 * bflo(c[u].x), w0 * bfhi(a[u].x) + w1 * bfhi(b[u].x) + w2 * bfhi(c[u].x));
                        o.y = cvt_pk_bf16(w0 * bflo(a[u].y) + w1 * bflo(b[u].y) + w2 * bflo(c[u].y), w0 * bfhi(a[u].y) + w1 * bfhi(b[u].y) + w2 * bfhi(c[u].y));
                        *(u32x2*)(catb + t * 512 + hh * 64 + d) = o; }
                }
            } else {
                if (p == 9 && l == 1)
                    conv_T(PP->in[30], D, KVW, (bf16_t*)(wreg + W_MIX_IN), PP->in[29], 0, 0, scr, gw, NGW, lane);
                if (p == 9 && l == 0) conv_group(PP, wreg, 1, 8, scr, gw, NGW, gtid, NGT, lane);
                if (p == 9 && l == 2) conv_group(PP, wreg, 3, 8, scr, gw, NGW, gtid, NGT, lane);
                if (p == 2 && l == 2) conv_group(PP, wreg, 2, 4 | 8, scr, gw, NGW, gtid, NGT, lane);
                const int nrep = (p == 1 && l == 0) ? 2 : 1;
                for (int rep = 0; rep < nrep; ++rep) {
                    const bf16_t* gA = xb; const bf16_t* gB = (const bf16_t*)wreg; int gM = T, gN = D, gK = D;
                    int e_mode = 2, e_perm = 1, e_ldo = 0; const float* e_ssq_in = nullptr; bf16_t* e_ob = nullptr; float e_scale = 0.f; float* e_ssq_out = nullptr;
                    const float* e_w0 = nullptr; const float* e_a0 = nullptr;
                    if (rep == 1) { gA = memb; gB = wmemkv; gM = 2048; gN = 2048; gK = D; e_ssq_in = memssq; e_ob = memkv; e_ldo = 2048; }
                    else if (p == 1) { gB = (bf16_t*)(wreg + W_FIN_PRE); gN = 2 * FF; e_mode = 0; e_ssq_in = ssq + 0; e_ob = hbuf; e_ldo = FF; }
                    else if (p == 2) { gA = hbuf; gB = (bf16_t*)(wreg + W_FOUT_PRE); gK = FF; e_mode = 1; e_perm = 0; e_scale = 0.5f; e_ob = xb; e_ssq_out = ssq + 0; }
                    else if (p == 3) { gB = (bf16_t*)(wreg + W_MIX_IN); gN = isA ? AIN : D; e_ssq_in = ssq + 0; e_ob = hbuf; e_ldo = isA ? AIN : D; }
                    else if (p == 5) { gA = aprep; gB = (bf16_t*)(wreg + W_LORA); gN = 2 * RW; gK = 256; e_mode = 3; e_ob = lora; e_ldo = LORA_N; e_w0 = PP->in[15] + li * RW; e_a0 = PP->in[17] + li * RW; }
                    else if (p == 8) { gA = isA ? cat : catb; gB = (bf16_t*)(wreg + W_MIX_OUT); gK = isA ? D : 512; e_mode = 1; e_perm = 0; e_scale = 1.0f; e_ob = xb; e_ssq_out = ssq + 0; }
                    else if (p == 9) { gB = (bf16_t*)(wreg + W_FIN_POST); gN = 2 * FF; e_mode = 0; e_ssq_in = ssq + 0; e_ob = hbuf; e_ldo = FF; }
                    else if (p == 10) { gA = hbuf; gB = (bf16_t*)(wreg + W_FOUT_POST); gK = FF; e_mode = 1; e_perm = 0; e_scale = 0.5f; e_ob = xb; e_ssq_out = ssq + 0; }
                    else { gB = (bf16_t*)(wreg + W_MIX_IN); gN = KVW; e_ssq_in = ssq + 0; e_ob = kvb; e_ldo = KVW; }
                    const pg8::Gemm g{gA, gB, gM, gN, gK};
                    const pg8::Epi E{e_mode, e_perm, (const gfloat*)e_ssq_in, (gbf16*)e_ob, e_ldo, (gfloat*)X, (const gfloat*)e_w0, (const gfloat*)e_a0};
                    if (p == 9 && l == 1) { __threadfence(); }
                    pg8::StaticOrder S; S.init(g.M, g.N, G, bx);
                    __syncthreads();
                    int tg = tid; asm volatile("" : "+v"(tg));
                    const float e_scale_s = __int_as_float(__builtin_amdgcn_readfirstlane(__float_as_int(e_scale)));
                    pg8::gemm_phase(lds, g, S, E, e_scale_s, (gfloat*)e_ssq_out, tg);
                    __syncthreads();
                }
            }
        } else if (p == 4) {
            if (isA) {
                const float* mu = PP->in[14] + (size_t)li * 2560 + 2304;
                const int j = ((int)gtid & 63) * 4;
                const f32x4 m4 = *(const f32x4*)(mu + j);
                for (long i0 = gtid; i0 < (long)T * 64; i0 += 4 * NGT) {
                    u32x2 a[4], b[4];
#pragma unroll
                    for (int u = 0; u < 4; ++u) { const long t = (i0 + u * NGT) >> 6;
                        a[u] = *(const u32x2*)(proj + t * AIN + 2304 + j);
                        const bool hp = (t & (SEQ - 1)) != 0; const unsigned mk = hp ? 0xffffffffu : 0u; b[u] = *(const u32x2*)(proj + (t - (hp ? 1 : 0)) * AIN + 2304 + j) & mk; }
#pragma unroll
                    for (int u = 0; u < 4; ++u) { const long t = (i0 + u * NGT) >> 6;
                        float v[4]; v[0] = bflo(a[u].x) + m4[0] * (bflo(b[u].x) - bflo(a[u].x)); v[1] = bfhi(a[u].x) + m4[1] * (bfhi(b[u].x) - bfhi(a[u].x));
                        v[2] = bflo(a[u].y) + m4[2] * (bflo(b[u].y) - bflo(a[u].y)); v[3] = bfhi(a[u].y) + m4[3] * (bfhi(b[u].y) - bfhi(a[u].y));
                        if (j < 64) {
#pragma unroll
                            for (int e = 0; e < 4; ++e) v[e] = 1.0f - 2.0f * __builtin_amdgcn_rcpf(1.0f + __expf(2.0f * v[e]));
                        } else if (j >= 128) {
#pragma unroll
                            for (int e = 0; e < 4; ++e) v[e] = sigmoidf_(v[e]);
                        }
                        u32x2 o; o.x = cvt_pk_bf16(v[0], v[1]); o.y = cvt_pk_bf16(v[2], v[3]);
                        *(u32x2*)(aprep + t * 256 + j) = o; }
                }
            }
            if (!isA) {
                AttnIn r;
                { const bf16_t* Qp; const bf16_t* Kp; const bf16_t* Vp; long qs, kvs; bool ck;
                  attn_decode_B(bx, l, qall, kvb, memkv, Qp, qs, Kp, Vp, kvs, ck); attn_issue(r, Qp, qs, Kp, Vp, kvs, ck, tid); }
                for (int u = bx; u < 4096; u += G) {
                    int tidu = tid; asm volatile("" : "+v"(tidu));
                    const int un = u + G; const bool hn = un < 4096;
                    const bf16_t* nQ = qall; const bf16_t* nK = kvb; const bf16_t* nV = kvb; long nqs = 0, nkvs = 0; bool nck = false;
                    if (hn) attn_decode_B(un, l, qall, kvb, memkv, nQ, nqs, nK, nV, nkvs, nck);
                    if (u < 3072) {
                        const int blk = u & 31, hh = (u >> 5) & 3, bg = u >> 7, g = bg % 3, b = bg / 3;
                        const int dil = (g == 0) ? 1 : ((g == 1) ? 4 : 16), nper = 32 / dil, c = blk / nper, n = blk % nper, head = g * 4 + hh;
                        const long tq0 = (long)b * SEQ + (long)(n * 128) * dil + c;
                        attn_run<1>(lds, r, n > 0 ? 1 : 0, PP->in[27] + li * 64, PP->in[31], PP->in[32], dil, head, og + tq0 * RW + head * 64, (long)dil * RW, lse + tq0 * 12 + head, (long)dil * 12, tidu,
                                    hn, nQ, nqs, nK, nV, nkvs, nck);
                    } else {
                        const int um = u - 3072, head = um & 3, tb = um >> 2; const long t0 = (long)tb * 128;
                        attn_run<0>(lds, r, 1, PP->in[11] + l * 64, PP->in[12] + l * 64, nullptr, 1, 0, catb + t0 * 512 + 256 + head * 64, 512, nullptr, 0, tidu,
                                    hn, nQ, nqs, nK, nV, nkvs, nck);
                    }
                }
            }
        } else if (p == 6) {
            if (bx >= 192) {
                const int sub = bx - 192, nsub = G - 192;
                for (int um = sub; um < 1024; um += nsub) {
                    int tidu = tid; asm volatile("" : "+v"(tidu));
                    const int head = um & 3, tb = um >> 2; const long t0 = (long)tb * 128; const int b = (int)(t0 / SEQ);
                    attn_unit<0>(lds, proj + t0 * AIN + 2560 + head * 64, AIN, memkv + (size_t)(b * 256) * 2048 + l * 512 + head * 64, memkv + (size_t)(b * 256) * 2048 + l * 512 + 256 + head * 64, 2048,
                                 1, PP->in[11] + l * 64, PP->in[12] + l * 64, nullptr, 1, 0, cat + t0 * D + RW + head * 64, D, nullptr, 0, tidu);
                }
                __syncthreads();
                {
                    const pg8::Gemm g2{aprep, (const bf16_t*)(wreg + W_LORA) + (size_t)(2 * RW) * 256, T, RW, 256};
                    const pg8::Epi E2{5, 1, (const gfloat*)nullptr, (gbf16*)(lora + 2 * RW), LORA_N, (gfloat*)X, (const gfloat*)nullptr, (const gfloat*)nullptr};
                    pg8::StaticOrder S2; S2.init(T, RW, nsub, sub);
                    int tg2 = tid; asm volatile("" : "+v"(tg2));
                    pg8::gemm_phase(lds, g2, S2, E2, 1.0f, (gfloat*)nullptr, tg2);
                    __syncthreads();
                }
                const int gw2 = sub * 8 + wave, NGW2 = nsub * 8; const long gtid2 = (long)sub * 512 + tid, NGT2 = (long)nsub * 512;
                conv_group(PP, wreg, l, 2, scr, gw2, NGW2, gtid2, NGT2, lane);
                conv_group(PP, wreg, l + 1, (l == 0) ? (1 | 4 | 16) : 1, scr, gw2, NGW2, gtid2, NGT2, lane);
            }
            for (int task = bx; task < 192; task += G) {
                const int half = (task >> 3) & 1, bh = (task & 7) + 8 * (task >> 4);
                const int b = bh / 12, h = bh % 12;
                scan_task(lds, b, h, half, proj, lora, yscan, PP->in[14] + (size_t)li * 2560, PP->in[20] + li * RW, PP->in[21] + li * RW, tid);
            }
        } else if (p == 7) {
            const float* mu = PP->in[14] + (size_t)li * 2560; const float* k_a = PP->in[21] + li * RW; const float* r_k = PP->in[22] + li * RW;
            const float* lng = PP->in[23] + li * RW; const float* lnb = PP->in[24] + li * RW;
            const int q3 = gw % 3, tstep = NGW / 3; const int col = q3 * 256 + lane * 4;
            const f32x4 mr = *(const f32x4*)(mu + col), mk = *(const f32x4*)(mu + RW + col), mv = *(const f32x4*)(mu + 2 * RW + col);
            const f32x4 ka = *(const f32x4*)(k_a + col), rk4 = *(const f32x4*)(r_k + col), g4 = *(const f32x4*)(lng + col), b4 = *(const f32x4*)(lnb + col);
#define POST_LOAD(T_, S) \
                const bool hp##S = ((T_) & (SEQ - 1)) != 0; \
                const u32x2 yv##S = *(const u32x2*)(yscan + (T_) * RW + col); \
                const bf16_t* pp##S = proj + (T_) * AIN + col; \
                const u32x2 rt##S = *(const u32x2*)pp##S, kt##S = *(const u32x2*)(pp##S + RW), vt##S = *(const u32x2*)(pp##S + 2 * RW); \
                const bf16_t* pq##S = pp##S - (hp##S ? AIN : 0); const unsigned msk##S = hp##S ? 0xffffffffu : 0u; \
                const u32x2 rp##S = *(const u32x2*)pq##S & msk##S, kp##S = *(const u32x2*)(pq##S + RW) & msk##S, vp##S = *(const u32x2*)(pq##S + 2 * RW) & msk##S; \
                const u32x2 av##S = *(const u32x2*)(lora + (T_) * LORA_N + RW + col), gv##S = *(const u32x2*)(lora + (T_) * LORA_N + 2 * RW + col);
#define POST_COMP(T_, S) { \
                float y[4] = {bflo(yv##S.x), bfhi(yv##S.x), bflo(yv##S.y), bfhi(yv##S.y)}; \
                const float r0[4] = {bflo(rt##S.x), bfhi(rt##S.x), bflo(rt##S.y), bfhi(rt##S.y)}, r1[4] = {bflo(rp##S.x), bfhi(rp##S.x), bflo(rp##S.y), bfhi(rp##S.y)}; \
                const float k0[4] = {bflo(kt##S.x), bfhi(kt##S.x), bflo(kt##S.y), bfhi(kt##S.y)}, k1[4] = {bflo(kp##S.x), bfhi(kp##S.x), bflo(kp##S.y), bfhi(kp##S.y)}; \
                const float v0[4] = {bflo(vt##S.x), bfhi(vt##S.x), bflo(vt##S.y), bfhi(vt##S.y)}, v1[4] = {bflo(vp##S.x), bfhi(vp##S.x), bflo(vp##S.y), bfhi(vp##S.y)}; \
                const float aa[4] = {bflo(av##S.x), bfhi(av##S.x), bflo(av##S.y), bfhi(av##S.y)}, gg[4] = {bflo(gv##S.x), bfhi(gv##S.x), bflo(gv##S.y), bfhi(gv##S.y)}; \
                float mean = allsum16((y[0] + y[1]) + (y[2] + y[3])) * (1.0f / 64.0f); \
                float var = 0.f, sb = 0.f, vs[4]; \
                _Pragma("unroll") for (int e = 0; e < 4; ++e) { y[e] -= mean; var += y[e] * y[e]; \
                    const float rs = r0[e] + mr[e] * (r1[e] - r0[e]), ks = k0[e] + mk[e] * (k1[e] - k0[e]); vs[e] = v0[e] + mv[e] * (v1[e] - v0[e]); \
                    sb += rs * ks * (1.0f + (aa[e] - 1.0f) * ka[e]) * rk4[e]; } \
                var = allsum16(var) * (1.0f / 64.0f); sb = allsum16(sb); \
                const float rstd = rsqrtf(var + 64e-5f); \
                float o[4]; \
                _Pragma("unroll") for (int e = 0; e < 4; ++e) o[e] = (y[e] * rstd * g4[e] + b4[e] + sb * vs[e]) * gg[e]; \
                u32x2 ow; ow.x = cvt_pk_bf16(o[0], o[1]); ow.y = cvt_pk_bf16(o[2], o[3]); \
                *(u32x2*)(cat + (T_) * D + col) = ow; }
            for (long t = (gw < 3 * tstep) ? gw / 3 : T; t < T; t += 2 * tstep) {
                const long tB = t + tstep; const bool hasB = tB < T; const long tBc = hasB ? tB : t;
                POST_LOAD(t, A)
                POST_LOAD(tBc, B)
                POST_COMP(t, A)
                if (hasB) POST_COMP(tB, B)
            }
#undef POST_LOAD
#undef POST_COMP
        }
#if MK_SINGLE
        if (it + 2 < P.ph_hi * 2) { if (it == 0) cg::this_grid().sync(); else { XcdBarrier xb_; xb_.bar = (unsigned*)(ws + WS_BAR); xb_.x = xb_xcc_id(); xb_.st = (volatile LAS unsigned*)(lds + MISC_OFF); xcd_barrier(xb_, tid); } }
#endif
    }
}

#undef lane
#undef wave
#undef gw
#undef NGW
#undef gtid
#undef NGT
#undef scr
extern "C" void kernel_launch(void* const* d_in, const int* in_sizes, int n_in, void* d_out, int out_size, void* d_ws, size_t ws_size, hipStream_t stream) {
    static int ready = 0;
    if (!ready) {
        if (n_in != 33 || out_size != T * D || ws_size < WS_END) { fprintf(stderr, "kernel_launch: unexpected shapes (n_in %d out %d ws %zu)\n", n_in, out_size, ws_size); ready = -1; return; }
        if (hipFuncSetAttribute((const void*)fwd_kernel, hipFuncAttributeMaxDynamicSharedMemorySize, LDS_BYTES) != hipSuccess) { fprintf(stderr, "kernel_launch: hipFuncSetAttribute failed\n"); ready = -1; return; }
        int per_cu = 0;
        hipOccupancyMaxActiveBlocksPerMultiprocessor(&per_cu, (const void*)fwd_kernel, 512, LDS_BYTES);
        if (per_cu < 1) fprintf(stderr, "kernel_launch: occupancy query says %d blocks per CU\n", per_cu);
        (void)hipGetLastError();
        ready = 1;
    }
    if (ready < 0) return;
    Params p{};
    for (int i = 0; i < 33; ++i) p.in[i] = (const float*)d_in[i];
    p.out = (float*)d_out; p.ws = (unsigned char*)d_ws;
    const int grid = 256;
#if MK_SINGLE
    hipMemsetAsync((char*)d_ws + WS_BAR, 0, 16384, stream);
    p.ph_lo = 0; p.ph_hi = 48;
    void* args[] = {&p};
    hipError_t e = hipLaunchCooperativeKernel((const void*)fwd_kernel, dim3(grid), dim3(512), args, LDS_BYTES, stream);
    if (e != hipSuccess) fprintf(stderr, "cooperative launch failed: %s\n", hipGetErrorString(e));
#else
    for (int ph = 0; ph < 48; ++ph) {
        const int l = ph / 12, q = ph % 12; const bool isA = l < 2;
        if ((!isA && (q == 6 || q == 7)) || (q == 11 && l != 1) || (q == 0 && l != 0)) continue;
        p.ph_lo = ph; p.ph_hi = ph + 1;
        hipLaunchKernelGGL(fwd_kernel, dim3(grid), dim3(512), LDS_BYTES, stream, p);
    }
#endif
}
```

```cpp
#include <hip/hip_runtime.h>
#include <hip/hip_cooperative_groups.h>
#include <cstdio>
namespace cg = cooperative_groups;

#ifndef MK_SINGLE
#define MK_SINGLE 1
#endif

#define LAS __attribute__((address_space(3)))
typedef unsigned short bf16_t;
typedef short bf16x8 __attribute__((ext_vector_type(8)));
typedef short bf16x4 __attribute__((ext_vector_type(4)));
typedef float f32x4 __attribute__((ext_vector_type(4)));
typedef float f32x2 __attribute__((ext_vector_type(2)));
typedef unsigned u32x4 __attribute__((ext_vector_type(4)));
typedef unsigned u32x2 __attribute__((ext_vector_type(2)));
#define GAS __attribute__((address_space(1)))
typedef GAS float gfloat;
typedef GAS unsigned short gbf16;

constexpr int T = 32768, D = 1024, FF = 2816, SEQ = 4096;
constexpr int AIN = 2816, RW = 768, LORA_N = 2304, KVW = 1536;
constexpr float NORM_EPS = 1e-6f;
constexpr size_t MiB = 1u << 20;
constexpr size_t WS_SSQ = 0;
constexpr size_t WS_MEMSSQ = 3584 * 1024;
constexpr size_t WS_LSE = 2 * MiB;
constexpr size_t WS_BAR = 3840 * 1024;
constexpr size_t WS_MEMB = 4 * MiB;
constexpr size_t WS_MEMKV = 8 * MiB;
constexpr size_t WS_W = 16 * MiB;
constexpr size_t WS_XB = 60 * MiB;
constexpr size_t WS_H = 124 * MiB;
constexpr size_t WS_LORA = 300 * MiB;
constexpr size_t WS_CAT = 444 * MiB;
constexpr size_t WS_END = 508 * MiB;
constexpr size_t W_FIN_PRE = 0, W_FOUT_PRE = 11 * MiB, W_FIN_POST = 16 * MiB + 512 * 1024, W_FOUT_POST = 27 * MiB + 512 * 1024,
                 W_MIX_IN = 33 * MiB, W_MIX_OUT = 38 * MiB + 512 * 1024, W_LORA = 40 * MiB + 512 * 1024;
constexpr int LDS_BYTES = 147456, MISC_OFF = 147456 - 64;
#ifndef EXP_DELAY
#define EXP_DELAY 0
#endif
#ifndef DUPMASK
#define DUPMASK 0
#endif

__device__ __forceinline__ unsigned cvt_pk_bf16(float lo, float hi) { unsigned r; asm volatile("v_cvt_pk_bf16_f32 %0, %1, %2" : "=v"(r) : "v"(lo), "v"(hi)); return r; }
__device__ __forceinline__ float bflo(unsigned u) { return __uint_as_float(u << 16); }
__device__ __forceinline__ float bfhi(unsigned u) { return __uint_as_float(u & 0xffff0000u); }
__device__ __forceinline__ float bf1(bf16_t v) { return __uint_as_float((unsigned)v << 16); }
__device__ __forceinline__ float sigmoidf_(float x) { return __builtin_amdgcn_rcpf(1.0f + __expf(-x)); }
__device__ __forceinline__ float xsum_rows(float s) {
    const auto r = __builtin_amdgcn_permlane16_swap(__float_as_uint(s), __float_as_uint(s), false, false);
    s = __uint_as_float(r[0]) + __uint_as_float(r[1]);
    const auto q = __builtin_amdgcn_permlane32_swap(__float_as_uint(s), __float_as_uint(s), false, false);
    return __uint_as_float(q[0]) + __uint_as_float(q[1]);
}
template <int CTRL> __device__ __forceinline__ float dpp_f(float v) { return __int_as_float(__builtin_amdgcn_update_dpp(0, __float_as_int(v), CTRL, 0xf, 0xf, false)); }
__device__ __forceinline__ float allsum16(float v) {
    v += dpp_f<0x128>(v);
    v += dpp_f<0x124>(v);
    v += dpp_f<0x122>(v);
    v += dpp_f<0x121>(v);
    return v;
}

namespace pg8 {
constexpr int BM = 256, BK = 64, HALF = 128, HTB = HALF * BK * 2, STAGE_BYTES = 8 * HTB, NXCD = 8, WGM = 8;
__device__ __forceinline__ int lds_byte(int r, int c) { const int st = (r >> 4) * 2 + (c >> 5), rr = r & 15, cc = c & 31, ob = rr * 64 + cc * 2; return st * 1024 + (ob ^ (((ob >> 9) & 1) << 5)); }
__device__ __forceinline__ void stage_rc(int b, int& R, int& C) { const int st = b / 1024, sb = b % 1024, swz = sb ^ (((sb >> 9) & 1) << 5); R = (st >> 1) * 16 + swz / 64; C = (st & 1) * 32 + (swz % 64) / 2; }
__device__ __forceinline__ int perm32(int rho) { const int n = rho >> 4, i = rho & 15; return 8 * (i >> 2) + 4 * n + (i & 3); }
struct Unit { int pm, pn; };
struct Gemm { const bf16_t* A; const bf16_t* Bt; int M, N, K; };
struct StaticOrder {
    int nM, nN, nwg, G, c;
    __device__ void init(int M, int N, int G_, int c_) { nM = M / BM; nN = N / BM; nwg = nM * nN; G = G_; c = c_; }
    __device__ bool next(int i, Unit& u) const {
        const long L = (long)i * G + c; if (L >= nwg) return false;
        int wgid = (int)L; { const int q = nwg / NXCD, r = nwg % NXCD, xcd = wgid % NXCD, off = wgid / NXCD; wgid = (xcd < r ? xcd * (q + 1) : r * (q + 1) + (xcd - r) * q) + off; }
        const int nig = WGM * nN, gid = wgid / nig, fm = gid * WGM, gsz = (nM - fm) < WGM ? (nM - fm) : WGM;
        u.pm = fm + ((wgid % nig) % gsz); u.pn = (wgid % nig) / gsz; return true;
    }
};

struct Epi {
    int mode, perm;
    const gfloat* ssq_in; gbf16* ob; int ldo;
    gfloat* x;
    const gfloat* w0; const gfloat* a0;
    template <int NR> __device__ __forceinline__ void rstdN(float (&rs)[NR], int rowbase, int fq) const {
        const GAS f32x4* bp = (const GAS f32x4*)(ssq_in + (size_t)rowbase * 16 + 4 * fq);
        f32x4 p[NR];
#pragma unroll
        for (int m = 0; m < NR; ++m) p[m] = bp[m * 64];
        asm volatile("" :: "v"(bp));
#pragma unroll
        for (int m = 0; m < NR; ++m) {
            float s = (p[m][0] + p[m][1]) + (p[m][2] + p[m][3]);
            s = xsum_rows(s);
            rs[m] = rsqrtf(s * (1.0f / 1024.0f) + NORM_EPS);
        }
    }
    __device__ __forceinline__ void rstd8(float (&rs)[2][4], int row0, int fq) const {
        const GAS f32x4* b0 = (const GAS f32x4*)(ssq_in + (size_t)row0 * 16 + 4 * fq);
        const GAS f32x4* b1 = (const GAS f32x4*)(ssq_in + (size_t)(row0 + HALF) * 16 + 4 * fq);
        f32x4 p[2][4];
#pragma unroll
        for (int m = 0; m < 4; ++m) { p[0][m] = b0[m * 64]; p[1][m] = b1[m * 64]; }
        asm volatile("" :: "v"(b0), "v"(b1));
#pragma unroll
        for (int ai = 0; ai < 2; ++ai)
#pragma unroll
            for (int m = 0; m < 4; ++m) {
                float s = (p[ai][m][0] + p[ai][m][1]) + (p[ai][m][2] + p[ai][m][3]);
                s = xsum_rows(s);
                rs[ai][m] = rsqrtf(s * (1.0f / 1024.0f) + NORM_EPS);
            }
    }
    __device__ __forceinline__ float row_rstd(int row, int fq) const {
        const f32x4 p = *(const GAS f32x4*)(ssq_in + (size_t)row * 16 + 4 * fq);
        float s = (p[0] + p[1]) + (p[2] + p[3]);
        s += __shfl_xor(s, 16); s += __shfl_xor(s, 32);
        return rsqrtf(s * (1.0f / 1024.0f) + NORM_EPS);
    }
    template <int KIND> __device__ __forceinline__ void epi_bf16(const f32x4 (&acc)[2][2][4][2], const Unit& u, int row0, int wc, int fq) const {
        const int colt = u.pn * BM + wc * 32 + 8 * fq;
        const int seg = (KIND == 1) ? 0 : ((KIND == 2) ? 1 : 2);
        f32x4 bv[2][2];
        if (KIND == 1 || KIND == 2) {
            const GAS f32x4* bp = (const GAS f32x4*)((KIND == 1 ? w0 : a0) + (colt - seg * RW));
            bv[0][0] = bp[0]; bv[0][1] = bp[1]; bv[1][0] = bp[32]; bv[1][1] = bp[33];
            asm volatile("" :: "v"(bp));
        }
#pragma unroll
        for (int ai = 0; ai < 2; ++ai) {
            float rsv[4] = {1.0f, 1.0f, 1.0f, 1.0f};
            if (KIND == 0) rstdN<4>(rsv, row0 + ai * HALF, fq);
#pragma unroll
            for (int m = 0; m < 4; ++m) {
                const int row = row0 + ai * HALF + m * 16;
                const float rs = rsv[m];
#pragma unroll
                for (int bj = 0; bj < 2; ++bj) {
                    const int col = colt + bj * HALF;
                    float v[8];
#pragma unroll
                    for (int n = 0; n < 2; ++n)
#pragma unroll
                        for (int j = 0; j < 4; ++j) v[n * 4 + j] = acc[ai][bj][m][n][j] * rs;
                    if (KIND == 1) {
#pragma unroll
                        for (int e = 0; e < 8; ++e) v[e] = -0.60653066f * sigmoidf_(bv[bj][e >> 2][e & 3] + v[e]);
                    } else if (KIND == 2) {
#pragma unroll
                        for (int e = 0; e < 8; ++e) v[e] = sigmoidf_(bv[bj][e >> 2][e & 3] + v[e]);
                    }
                    u32x4 w; w.x = cvt_pk_bf16(v[0], v[1]); w.y = cvt_pk_bf16(v[2], v[3]); w.z = cvt_pk_bf16(v[4], v[5]); w.w = cvt_pk_bf16(v[6], v[7]);
                    *(GAS u32x4*)(ob + (size_t)row * ldo + col) = w;
                }
            }
        }
    }
    template <int AI, int M0> __device__ __forceinline__ void epi1_pair(const f32x4 (&acc)[2][2][4][2], int row0, int col0, int fq, const float scale, gfloat* ssq_out, int slot) const {
        const int rowa = row0 + AI * HALF + M0 * 16, rowb = rowa + 16;
        GAS f32x4* xa = (GAS f32x4*)(x + (size_t)rowa * D + col0); GAS f32x4* xb_ = (GAS f32x4*)(x + (size_t)rowb * D + col0);
        f32x4 va[2][2], vb[2][2];
#pragma unroll
        for (int bj = 0; bj < 2; ++bj)
#pragma unroll
            for (int n = 0; n < 2; ++n) { va[bj][n] = xa[bj * 32 + n * 4]; vb[bj][n] = xb_[bj * 32 + n * 4]; }
        asm volatile("" :: "v"(xa), "v"(xb_));
        GAS u32x2* oa = (GAS u32x2*)(ob + (size_t)rowa * D + col0); GAS u32x2* ob2 = (GAS u32x2*)(ob + (size_t)rowb * D + col0);
        float ssa = 0.f, ssb = 0.f;
#pragma unroll
        for (int bj = 0; bj < 2; ++bj)
#pragma unroll
            for (int n = 0; n < 2; ++n) {
                const f32x4 a = va[bj][n] + acc[AI][bj][M0][n] * scale, b = vb[bj][n] + acc[AI][bj][M0 + 1][n] * scale;
                xa[bj * 32 + n * 4] = a; xb_[bj * 32 + n * 4] = b;
                u32x2 wa; wa.x = cvt_pk_bf16(a[0], a[1]); wa.y = cvt_pk_bf16(a[2], a[3]); oa[bj * 32 + n * 4] = wa;
                u32x2 wb; wb.x = cvt_pk_bf16(b[0], b[1]); wb.y = cvt_pk_bf16(b[2], b[3]); ob2[bj * 32 + n * 4] = wb;
                ssa += (a[0] * a[0] + a[1] * a[1]) + (a[2] * a[2] + a[3] * a[3]);
                ssb += (b[0] * b[0] + b[1] * b[1]) + (b[2] * b[2] + b[3] * b[3]);
            }
        ssa = xsum_rows(ssa); ssb = xsum_rows(ssb);
        if (fq == 0) { ssq_out[(size_t)rowa * 16 + slot] = ssa; ssq_out[(size_t)rowb * 16 + slot] = ssb; }
    }
    __device__ __forceinline__ void operator()(const f32x4 (&acc)[2][2][4][2], const Unit& u, int wr, int wc, int fr, int fq, const float scale, gfloat* ssq_out) const {
        const int row0 = u.pm * BM + wr * 64 + fr;
        if (mode == 0) {
            const int col0 = u.pn * 128 + wc * 32 + 8 * fq;
#pragma unroll
            for (int ai = 0; ai < 2; ++ai) {
                float rsv[4];
                rstdN<4>(rsv, row0 + ai * HALF, fq);
#pragma unroll
                for (int m = 0; m < 4; ++m) {
                    const int row = row0 + ai * HALF + m * 16;
                    const float rs = rsv[m];
                    float hv[8];
#pragma unroll
                    for (int n = 0; n < 2; ++n)
#pragma unroll
                        for (int j = 0; j < 4; ++j) { const float g = acc[ai][0][m][n][j] * rs, up = acc[ai][1][m][n][j] * rs; hv[n * 4 + j] = g * up * __builtin_amdgcn_rcpf(1.0f + __expf(-g)); }
                    u32x4 w; w.x = cvt_pk_bf16(hv[0], hv[1]); w.y = cvt_pk_bf16(hv[2], hv[3]); w.z = cvt_pk_bf16(hv[4], hv[5]); w.w = cvt_pk_bf16(hv[6], hv[7]);
                    *(GAS u32x4*)(ob + (size_t)row * ldo + col0) = w;
                }
            }
        } else if (mode == 1) {
            const int col0 = u.pn * BM + wc * 32 + 4 * fq;
            epi1_pair<0, 0>(acc, row0, col0, fq, scale, ssq_out, u.pn * 4 + wc); epi1_pair<0, 2>(acc, row0, col0, fq, scale, ssq_out, u.pn * 4 + wc);
            epi1_pair<1, 0>(acc, row0, col0, fq, scale, ssq_out, u.pn * 4 + wc); epi1_pair<1, 2>(acc, row0, col0, fq, scale, ssq_out, u.pn * 4 + wc);
        } else {
            if (mode == 2) epi_bf16<0>(acc, u, row0, wc, fq);
            else { const int seg = u.pn / 3; if (seg == 0) epi_bf16<1>(acc, u, row0, wc, fq); else if (seg == 1) epi_bf16<2>(acc, u, row0, wc, fq); else epi_bf16<3>(acc, u, row0, wc, fq); }
        }
    }
};

__device__ __forceinline__ void gemm_phase(LAS unsigned char* lds, const Gemm g, const StaticOrder& S, const Epi E, const float e_scale, gfloat* e_ssq_out, const int tid) {
    const int wid = __builtin_amdgcn_readfirstlane(tid >> 6), lane = tid & 63, wr = wid >> 2, wc = wid & 3, fr = lane & 15, fq = lane >> 4;
    const int K = g.K, nt = K / BK;
    unsigned voffA[2], voffB[2];
#pragma unroll
    for (int i = 0; i < 2; ++i) { int R, C; stage_rc(tid * 16 + i * 8192, R, C); const int Rb = E.perm ? ((R & ~31) + perm32(R & 31)) : R;
        voffA[i] = (unsigned)(R * K + C) * 2u; voffB[i] = (unsigned)(Rb * K + C) * 2u; }
    const size_t kstep = (size_t)(BK * 2);
    const size_t hstep = (size_t)HALF * K * 2;
    const size_t tstep = 2 * hstep;
    const unsigned ldsw = (unsigned)wid * 1024u;
    const int aoff = lds_byte(wr * 64 + fr, fq * 8), boff = lds_byte(wc * 32 + fr, fq * 8);
#define PG8_SA(b, h) (((b) * 2 + (h)) * HTB)
#define PG8_SB(b, h) ((4 + (b) * 2 + (h)) * HTB)
#define PG8_STAGE(bufoff, gbase, voff) do { _Pragma("unroll") for (int _i = 0; _i < 2; ++_i) \
        __builtin_amdgcn_global_load_lds((const unsigned*)((const char*)(gbase) + (voff)[_i]), (LAS unsigned*)(lds + (bufoff) + ldsw + _i * 8192), 16, 0, 0); } while (0)
#define PG8_LDA(dst, b, h) do { _Pragma("unroll") for (int m = 0; m < 4; ++m) _Pragma("unroll") for (int k = 0; k < 2; ++k) dst[m][k] = *(const LAS bf16x8*)(lds + PG8_SA(b, h) + aoff + m * 2048 + k * 1024); } while (0)
#define PG8_LDB(dst, b, h) do { _Pragma("unroll") for (int n = 0; n < 2; ++n) _Pragma("unroll") for (int k = 0; k < 2; ++k) dst[n][k] = *(const LAS bf16x8*)(lds + PG8_SB(b, h) + boff + n * 2048 + k * 1024); } while (0)
#define PG8_MMA(ai, bj, At, Bt) do { __builtin_amdgcn_s_setprio(1); _Pragma("unroll") for (int m = 0; m < 4; ++m) _Pragma("unroll") for (int n = 0; n < 2; ++n) _Pragma("unroll") for (int k = 0; k < 2; ++k) \
        acc[ai][bj][m][n] = __builtin_amdgcn_mfma_f32_16x16x32_bf16(Bt[n][k], At[m][k], acc[ai][bj][m][n], 0, 0, 0); __builtin_amdgcn_s_setprio(0); } while (0)
#define PG8_WAIT_V(n) asm volatile("s_waitcnt vmcnt(" #n ")" ::: "memory")
#define PG8_WAIT_L(n) asm volatile("s_waitcnt lgkmcnt(" #n ")" ::: "memory")
#define PG8_BAR __builtin_amdgcn_s_barrier()
#define PG8_SCHED __builtin_amdgcn_sched_barrier(0)
    Unit cur, nxt; int ui = 0;
    if (!S.next(0, cur)) return;
    f32x4 acc[2][2][4][2];
#pragma unroll
    for (int a = 0; a < 2; ++a)
#pragma unroll
        for (int b = 0; b < 2; ++b)
#pragma unroll
            for (int m = 0; m < 4; ++m)
#pragma unroll
                for (int n = 0; n < 2; ++n) acc[a][b][m][n] = (f32x4){0.f, 0.f, 0.f, 0.f};
    bf16x8 At[4][2], B0[2][2], B1[2][2];
    const char* cA = (const char*)g.A + (size_t)cur.pm * tstep; const char* cB = (const char*)g.Bt + (size_t)cur.pn * tstep;
    PG8_STAGE(PG8_SB(0, 0), cB, voffB); PG8_STAGE(PG8_SA(0, 0), cA, voffA); PG8_STAGE(PG8_SB(0, 1), cB + hstep, voffB); PG8_STAGE(PG8_SA(0, 1), cA + hstep, voffA);
    if (wr == 1) PG8_BAR;
    PG8_WAIT_V(4); PG8_BAR;
    PG8_STAGE(PG8_SB(1, 0), cB + kstep, voffB); PG8_STAGE(PG8_SA(1, 0), cA + kstep, voffA); PG8_STAGE(PG8_SB(1, 1), cB + hstep + kstep, voffB);
    PG8_WAIT_V(6); PG8_BAR;
    for (;;) {
        const bool has_next = S.next(ui + 1, nxt);
        const char* nA = has_next ? (const char*)g.A + (size_t)nxt.pm * tstep : cA; const char* nB = has_next ? (const char*)g.Bt + (size_t)nxt.pn * tstep : cB;
        for (int t = 0; t < nt; t += 2) {
            const bool last = (t == nt - 2);
            const char* a1 = cA + (size_t)(t + 1) * kstep;
            const char* a2 = last ? nA : cA + (size_t)(t + 2) * kstep; const char* b2 = last ? nB : cB + (size_t)(t + 2) * kstep;
            const char* a3 = a2 + kstep; const char* b3 = b2 + kstep;
            PG8_LDB(B0, 0, 0); PG8_SCHED; PG8_LDA(At, 0, 0); PG8_STAGE(PG8_SA(1, 1), a1 + hstep, voffA);
            PG8_WAIT_L(8); PG8_BAR; PG8_WAIT_L(0); PG8_MMA(0, 0, At, B0); PG8_BAR; PG8_SCHED;
            PG8_LDB(B1, 0, 1); PG8_STAGE(PG8_SB(0, 0), b2, voffB);
            PG8_BAR; PG8_WAIT_L(0); PG8_MMA(0, 1, At, B1); PG8_BAR;
            PG8_LDA(At, 0, 1); PG8_STAGE(PG8_SA(0, 0), a2, voffA);
            PG8_BAR; PG8_WAIT_L(0); PG8_MMA(1, 0, At, B0); PG8_BAR; PG8_SCHED;
            PG8_STAGE(PG8_SB(0, 1), b2 + hstep, voffB);
            PG8_WAIT_V(6); PG8_BAR; PG8_MMA(1, 1, At, B1); PG8_BAR;
            PG8_LDB(B0, 1, 0); PG8_SCHED; PG8_LDA(At, 1, 0); PG8_STAGE(PG8_SA(0, 1), a2 + hstep, voffA);
            PG8_WAIT_L(8); PG8_BAR; PG8_WAIT_L(0); PG8_MMA(0, 0, At, B0); PG8_BAR; PG8_SCHED;
            PG8_LDB(B1, 1, 1); PG8_STAGE(PG8_SB(1, 0), b3, voffB);
            PG8_BAR; PG8_WAIT_L(0); PG8_MMA(0, 1, At, B1); PG8_BAR;
            PG8_LDA(At, 1, 1); PG8_STAGE(PG8_SA(1, 0), a3, voffA);
            PG8_BAR; PG8_WAIT_L(0); PG8_MMA(1, 0, At, B0); PG8_BAR; PG8_SCHED;
            PG8_STAGE(PG8_SB(1, 1), b3 + hstep, voffB);
            PG8_WAIT_V(6); PG8_BAR; PG8_MMA(1, 1, At, B1); PG8_BAR;
        }
        E(acc, cur, wr, wc, fr, fq, e_scale, e_ssq_out);
#if EXP_DELAY
        if (E.mode == 0) { __builtin_amdgcn_s_sleep(100); __builtin_amdgcn_s_sleep(100); }
#endif
        if (!has_next) break;
#pragma unroll
        for (int a = 0; a < 2; ++a)
#pragma unroll
            for (int b = 0; b < 2; ++b)
#pragma unroll
                for (int m = 0; m < 4; ++m)
#pragma unroll
                    for (int n = 0; n < 2; ++n) acc[a][b][m][n] = (f32x4){0.f, 0.f, 0.f, 0.f};
        cur = nxt; cA = nA; cB = nB; ++ui;
    }
    PG8_WAIT_V(0);
    if (wr == 0) PG8_BAR;
    PG8_BAR;
#undef PG8_SA
#undef PG8_SB
#undef PG8_STAGE
#undef PG8_LDA
#undef PG8_LDB
#undef PG8_MMA
#undef PG8_WAIT_V
#undef PG8_WAIT_L
#undef PG8_BAR
#undef PG8_SCHED
}
}

struct Params { const float* in[33]; float* out; unsigned char* ws; int ph_lo, ph_hi; };

__device__ __forceinline__ void conv_T(const float* W, int K, int N, bf16_t* WT, const float* gain, int swi, int row_off, LAS float* scr, int gw, int NGW, int lane) {
    const int nblk = N / 32, nitems = (K / 64) * nblk;
    f32x4 tv[8];
    if (gw < nitems) {
        const int kb = gw / nblk, nb = gw % nblk;
        const float* wp = W + (size_t)(64 * kb + (lane >> 3)) * N + 32 * nb + 4 * (lane & 7);
#pragma unroll
        for (int i = 0; i < 8; ++i) tv[i] = *(const f32x4*)(wp + (size_t)(8 * i) * N);
    }
    for (int item = gw; item < nitems; item += NGW) {
        const int kb = item / nblk, nb = item % nblk, k0 = 64 * kb, n0 = 32 * nb;
#pragma unroll
        for (int i = 0; i < 8; ++i) { LAS float* d = scr + (8 * i + (lane >> 3)) * 33 + 4 * (lane & 7); d[0] = tv[i][0]; d[1] = tv[i][1]; d[2] = tv[i][2]; d[3] = tv[i][3]; }
        if (item + NGW < nitems) {
            const int it2 = item + NGW, kb2 = it2 / nblk, nb2 = it2 % nblk;
            const float* wp = W + (size_t)(64 * kb2 + (lane >> 3)) * N + 32 * nb2 + 4 * (lane & 7);
#pragma unroll
            for (int i = 0; i < 8; ++i) tv[i] = *(const f32x4*)(wp + (size_t)(8 * i) * N);
        }
        asm volatile("s_waitcnt lgkmcnt(0)" ::: "memory");
        int drow0;
        if (swi) { const int j0 = (n0 < FF) ? n0 : n0 - FF; drow0 = 256 * (j0 >> 7) + (j0 & 127) + ((n0 < FF) ? 0 : 128); } else drow0 = row_off + n0;
        const int c = lane & 7;
        float gv[8];
#pragma unroll
        for (int e = 0; e < 8; ++e) gv[e] = gain ? gain[k0 + 8 * c + e] : 1.0f;
#pragma unroll
        for (int j = 0; j < 4; ++j) { const int n = (lane >> 3) + 8 * j; const LAS float* s = scr + (8 * c) * 33 + n;
            u32x4 o; o.x = cvt_pk_bf16(s[0 * 33] * gv[0], s[1 * 33] * gv[1]); o.y = cvt_pk_bf16(s[2 * 33] * gv[2], s[3 * 33] * gv[3]);
            o.z = cvt_pk_bf16(s[4 * 33] * gv[4], s[5 * 33] * gv[5]); o.w = cvt_pk_bf16(s[6 * 33] * gv[6], s[7 * 33] * gv[7]);
            *(u32x4*)(WT + (size_t)(drow0 + n) * K + k0 + 8 * c) = o; }
        asm volatile("s_waitcnt lgkmcnt(0)" ::: "memory");
    }
}

constexpr int KS_PITCH = 72, VT_PITCH = 272;
constexpr int AT_KS = 0, AT_VT = 256 * KS_PITCH * 2, AT_RK = AT_VT + 64 * VT_PITCH * 2, AT_TB = AT_RK + 1024;
struct AttnIn { u32x4 k[4], v[4], q0, q1; };
__device__ __forceinline__ void attn_issue_kv(AttnIn& r, const bf16_t* Kp, const bf16_t* Vp, long kv_stride, bool clampk, const int tid) {
#pragma unroll
    for (int i = 0; i < 4; ++i) {
        { const int id = tid + 512 * i, key = id >> 3, ck = id & 7; const int krow = (clampk && key < 128) ? key + 128 : key;
          r.k[i] = *(const u32x4*)(Kp + (long)krow * kv_stride + ck * 8); }
        { const int id = tid + 512 * i, key = id & 255, ck = id >> 8; const int krow = (clampk && key < 128) ? key + 128 : key;
          r.v[i] = *(const u32x4*)(Vp + (long)krow * kv_stride + ck * 8); }
    }
}
__device__ __forceinline__ void attn_issue_q(AttnIn& r, const bf16_t* Qp, long q_stride, const int tid) {
    const int lane = tid & 63, w = tid >> 6, fr = lane & 15, fq = lane >> 4;
    const int qi = 16 * w + fr;
    r.q0 = *(const u32x4*)(Qp + (long)qi * q_stride + 8 * fq); r.q1 = *(const u32x4*)(Qp + (long)qi * q_stride + 32 + 8 * fq);
}
__device__ __forceinline__ void attn_issue(AttnIn& r, const bf16_t* Qp, long q_stride, const bf16_t* Kp, const bf16_t* Vp, long kv_stride, bool clampk, const int tid) {
    attn_issue_kv(r, Kp, Vp, kv_stride, clampk, tid); attn_issue_q(r, Qp, q_stride, tid);
}
template <int MODE> __device__ __forceinline__ void attn_run(LAS unsigned char* lds, AttnIn& r,
                                          int first, const float* qg1, const float* qg2, const float* rel_bias, int dil, int head,
                                          bf16_t* Op, long o_stride, float* lsep, long lse_stride, const int tid,
                                          bool has_next, const bf16_t* nQp, long nq_stride, const bf16_t* nKp, const bf16_t* nVp, long nkv_stride, bool nclamp) {
    const int lane = tid & 63, w = tid >> 6, fr = lane & 15, fq = lane >> 4;
    LAS bf16_t* Ks = (LAS bf16_t*)(lds + AT_KS); LAS bf16_t* Vt = (LAS bf16_t*)(lds + AT_VT);
    LAS float* rk = (LAS float*)(lds + AT_RK); LAS float* tb = (LAS float*)(lds + AT_TB);
    __syncthreads();
#pragma unroll
    for (int i = 0; i < 4; ++i) {
        { const int id = tid + 512 * i, key = id >> 3, ck = id & 7;
          const u32x4 kx = r.k[i];
          *(LAS u32x4*)(Ks + key * KS_PITCH + ck * 8) = kx;
          float ss = 0.f;
#pragma unroll
          for (int e = 0; e < 4; ++e) { const float a = bflo(kx[e]), b = bfhi(kx[e]); ss += a * a + b * b; }
          ss += __shfl_xor(ss, 1); ss += __shfl_xor(ss, 2); ss += __shfl_xor(ss, 4);
          if (ck == 0) rk[key] = rsqrtf(ss * (1.0f / 64.0f) + NORM_EPS); }
        { const int id = tid + 512 * i, key = id & 255, ck = id >> 8;
          const u32x4 vx = r.v[i];
#pragma unroll
          for (int e = 0; e < 4; ++e) { Vt[(ck * 8 + 2 * e) * VT_PITCH + key] = (bf16_t)(vx[e] & 0xffffu); Vt[(ck * 8 + 2 * e + 1) * VT_PITCH + key] = (bf16_t)(vx[e] >> 16); } }
    }
    if (MODE == 1 && tid < 129) {
        const int dist = tid * dil; int bucket;
        if (dist < 16) bucket = dist;
        else { const float v = logf((float)dist / 16.0f) / 4.852030263919617f * 16.0f; int lg = 16 + (int)v; bucket = lg < 31 ? lg : 31; }
        tb[tid] = rel_bias[bucket * 12 + head];
    }
    const int qi = 16 * w + fr;
    bf16x8 Qf0, Qf1; float rq;
    {
        const u32x4 q0 = r.q0, q1 = r.q1;
        float v0[8], v1[8]; float ss = 0.f;
#pragma unroll
        for (int e = 0; e < 4; ++e) { v0[2 * e] = bflo(q0[e]); v0[2 * e + 1] = bfhi(q0[e]); v1[2 * e] = bflo(q1[e]); v1[2 * e + 1] = bfhi(q1[e]); }
#pragma unroll
        for (int e = 0; e < 8; ++e) ss += v0[e] * v0[e] + v1[e] * v1[e];
        ss += __shfl_xor(ss, 16); ss += __shfl_xor(ss, 32);
        rq = rsqrtf(ss * (1.0f / 64.0f) + NORM_EPS) * 0.125f;
#pragma unroll
        for (int e = 0; e < 8; ++e) { v0[e] *= qg1[8 * fq + e] * qg2[8 * fq + e]; v1[e] *= qg1[32 + 8 * fq + e] * qg2[32 + 8 * fq + e]; }
        u32x4 a, b;
        a.x = cvt_pk_bf16(v0[0], v0[1]); a.y = cvt_pk_bf16(v0[2], v0[3]); a.z = cvt_pk_bf16(v0[4], v0[5]); a.w = cvt_pk_bf16(v0[6], v0[7]);
        b.x = cvt_pk_bf16(v1[0], v1[1]); b.y = cvt_pk_bf16(v1[2], v1[3]); b.z = cvt_pk_bf16(v1[4], v1[5]); b.w = cvt_pk_bf16(v1[6], v1[7]);
        Qf0 = __builtin_bit_cast(bf16x8, a); Qf1 = __builtin_bit_cast(bf16x8, b);
    }
    if (has_next) attn_issue_kv(r, nKp, nVp, nkv_stride, nclamp, tid);
    __syncthreads();
    constexpr int NB = (MODE == 1) ? 9 : 16, NS = (MODE == 1) ? 10 : 16;
    f32x4 s[NS];
#pragma unroll
    for (int i = 0; i < NB; ++i) {
        const int nb = (MODE == 1) ? (w + i) : i;
        const bf16x8 ka0 = *(const LAS bf16x8*)(Ks + (16 * nb + fr) * KS_PITCH + 8 * fq), ka1 = *(const LAS bf16x8*)(Ks + (16 * nb + fr) * KS_PITCH + 32 + 8 * fq);
        f32x4 z = (f32x4){0.f, 0.f, 0.f, 0.f};
        z = __builtin_amdgcn_mfma_f32_16x16x32_bf16(ka0, Qf0, z, 0, 0, 0);
        s[i] = __builtin_amdgcn_mfma_f32_16x16x32_bf16(ka1, Qf1, z, 0, 0, 0);
    }
    if (has_next) attn_issue_q(r, nQp, nq_stride, tid);
    if (MODE == 1) s[9] = (f32x4){0.f, 0.f, 0.f, 0.f};
    float mx = -3.0e38f;
#pragma unroll
    for (int i = 0; i < NB; ++i)
#pragma unroll
        for (int j = 0; j < 4; ++j) {
            const int key = 16 * ((MODE == 1) ? (w + i) : i) + 4 * fq + j;
            float lg = s[i][j] * rq * rk[key];
            if (MODE == 1) {
                const int dsub = 128 + qi - key;
                const bool valid = (dsub >= 0) && (dsub <= 128) && (first || key >= 128);
                const int di = dsub < 0 ? 0 : (dsub > 128 ? 128 : dsub);
                lg = valid ? lg + tb[di] : -1.0e30f;
            }
            s[i][j] = lg; mx = fmaxf(mx, lg);
        }
    mx = fmaxf(mx, __shfl_xor(mx, 16)); mx = fmaxf(mx, __shfl_xor(mx, 32));
    float l = 0.f;
#pragma unroll
    for (int i = 0; i < NB; ++i)
#pragma unroll
        for (int j = 0; j < 4; ++j) { const float p = __expf(s[i][j] - mx); s[i][j] = p; l += p; }
    l += __shfl_xor(l, 16); l += __shfl_xor(l, 32);
    f32x4 o[4];
#pragma unroll
    for (int nd = 0; nd < 4; ++nd) o[nd] = (f32x4){0.f, 0.f, 0.f, 0.f};
#pragma unroll
    for (int kb = 0; kb < NS / 2; ++kb) {
        u32x4 pa; pa.x = cvt_pk_bf16(s[2 * kb][0], s[2 * kb][1]); pa.y = cvt_pk_bf16(s[2 * kb][2], s[2 * kb][3]);
        pa.z = cvt_pk_bf16(s[2 * kb + 1][0], s[2 * kb + 1][1]); pa.w = cvt_pk_bf16(s[2 * kb + 1][2], s[2 * kb + 1][3]);
        const bf16x8 pf = __builtin_bit_cast(bf16x8, pa);
        int k0 = 32 * kb, k1 = 32 * kb + 16;
        if (MODE == 1) { k0 = 16 * (w + 2 * kb); const int b1 = w + 2 * kb + 1; k1 = 16 * (b1 > 15 ? 15 : b1); }
#pragma unroll
        for (int nd = 0; nd < 4; ++nd) {
            const LAS bf16_t* vp = Vt + (16 * nd + fr) * VT_PITCH + 4 * fq;
            const u32x2 v0 = *(const LAS u32x2*)(vp + k0), v1 = *(const LAS u32x2*)(vp + k1);
            u32x4 vb; vb.x = v0.x; vb.y = v0.y; vb.z = v1.x; vb.w = v1.y;
            o[nd] = __builtin_amdgcn_mfma_f32_16x16x32_bf16(pf, __builtin_bit_cast(bf16x8, vb), o[nd], 0, 0, 0);
        }
    }
    const float linv = 1.0f / l;
#pragma unroll
    for (int j = 0; j < 4; ++j) {
        const float li = __shfl(linv, 4 * fq + j);
        bf16_t* orow = Op + (long)(16 * w + 4 * fq + j) * o_stride;
#pragma unroll
        for (int nd = 0; nd < 4; ++nd) orow[16 * nd + fr] = (bf16_t)(cvt_pk_bf16(o[nd][j] * li, 0.f) & 0xffffu);
    }
    if (MODE == 1 && fq == 0) lsep[(long)qi * lse_stride] = mx + logf(l);
}
template <int MODE> __device__ __forceinline__ void attn_unit(LAS unsigned char* lds, const bf16_t* Qp, long q_stride, const bf16_t* Kp, const bf16_t* Vp, long kv_stride,
                                          int first, const float* qg1, const float* qg2, const float* rel_bias, int dil, int head,
                                          bf16_t* Op, long o_stride, float* lsep, long lse_stride, const int tid) {
    AttnIn r;
    attn_issue(r, Qp, q_stride, Kp, Vp, kv_stride, (MODE == 1) && !first, tid);
    attn_run<MODE>(lds, r, first, qg1, qg2, rel_bias, dil, head, Op, o_stride, lsep, lse_stride, tid, false, nullptr, 0, nullptr, nullptr, 0, false);
}
__device__ __forceinline__ void attn_decode_B(int u, int l, const bf16_t* qall, const bf16_t* kvb, const bf16_t* memkv,
                                              const bf16_t*& Qp, long& qs, const bf16_t*& Kp, const bf16_t*& Vp, long& kvs, bool& clampk) {
    if (u < 3072) {
        const int blk = u & 31, hh = (u >> 5) & 3, bg = u >> 7, g = bg % 3, b = bg / 3;
        const int dil = (g == 0) ? 1 : ((g == 1) ? 4 : 16), nper = 32 / dil, c = blk / nper, n = blk % nper, head = g * 4 + hh;
        const long tq0 = (long)b * SEQ + (long)(n * 128) * dil + c, tk0 = tq0 - 128L * dil;
        Qp = qall + tq0 * D + head * 64; qs = (long)dil * D; Kp = kvb + tk0 * KVW + head * 64; Vp = Kp + RW; kvs = (long)dil * KVW; clampk = (n == 0);
    } else {
        const int um = u - 3072, head = um & 3, tb = um >> 2; const long t0 = (long)tb * 128; const int b = (int)(t0 / SEQ);
        Qp = qall + t0 * D + RW + head * 64; qs = D; Kp = memkv + (size_t)(b * 256) * 2048 + l * 512 + head * 64; Vp = Kp + 256; kvs = 2048; clampk = false;
    }
}

constexpr int SC_TC = 32;
constexpr int SC_OPS = 0, SC_YB = 2 * SC_TC * 384 * 4, SC_CST = SC_YB + 16 * 512 * 4;
__device__ __forceinline__ void scan_fill(LAS float* opsd, const LAS float* cst, int ht, int tpos0, size_t tok0, int h, const bf16_t* proj, const bf16_t* lora) {
    const int htt = ht >> 4, hch = (ht & 15) * 4;
    const int tpos = tpos0 + htt; const size_t t_ = tok0 + tpos; const bool hp = tpos > 0;
    const bf16_t* p_ = proj + t_ * AIN + h * 64 + hch; const bf16_t* pq_ = p_ - (hp ? AIN : 0); const unsigned mk_ = hp ? 0xffffffffu : 0u;
    const u32x2 r_t = *(const u32x2*)p_, k_t = *(const u32x2*)(p_ + RW), v_t = *(const u32x2*)(p_ + 2 * RW);
    const u32x2 r_p = *(const u32x2*)pq_ & mk_, k_p = *(const u32x2*)(pq_ + RW) & mk_, v_p = *(const u32x2*)(pq_ + 2 * RW) & mk_;
    const bf16_t* l_ = lora + t_ * LORA_N + h * 64 + hch;
    const u32x2 pw = *(const u32x2*)l_, pa = *(const u32x2*)(l_ + RW);
    const f32x4 mur = *(const LAS f32x4*)(cst + hch), muk = *(const LAS f32x4*)(cst + 64 + hch), muv = *(const LAS f32x4*)(cst + 128 + hch),
                kks = *(const LAS f32x4*)(cst + 192 + hch), kav = *(const LAS f32x4*)(cst + 256 + hch);
    f32x4 rs, ks, vs, wv, av, kr; float ss = 0.f;
#pragma unroll
    for (int e = 0; e < 4; ++e) {
        const unsigned sh = e >> 1; const bool hi = e & 1;
        const float rt = hi ? bfhi(r_t[sh]) : bflo(r_t[sh]), rp = hi ? bfhi(r_p[sh]) : bflo(r_p[sh]);
        const float kt = hi ? bfhi(k_t[sh]) : bflo(k_t[sh]), kp = hi ? bfhi(k_p[sh]) : bflo(k_p[sh]);
        const float vt = hi ? bfhi(v_t[sh]) : bflo(v_t[sh]), vp = hi ? bfhi(v_p[sh]) : bflo(v_p[sh]);
        rs[e] = rt + mur[e] * (rp - rt); ks[e] = kt + muk[e] * (kp - kt); vs[e] = vt + muv[e] * (vp - vt);
        wv[e] = __expf(hi ? bfhi(pw[sh]) : bflo(pw[sh])); av[e] = hi ? bfhi(pa[sh]) : bflo(pa[sh]);
        kr[e] = ks[e] * kks[e]; ss += kr[e] * kr[e];
    }
    ss = allsum16(ss);
    const float inv = 1.0f / fmaxf(sqrtf(ss), 1e-12f);
    LAS float* o = opsd + htt * 384 + hch;
    f32x4 t0;
    *(LAS f32x4*)(o) = wv;
    t0 = kr * (-inv); *(LAS f32x4*)(o + 64) = t0;
    t0 = kr * inv * av; *(LAS f32x4*)(o + 128) = t0;
#pragma unroll
    for (int e = 0; e < 4; ++e) t0[e] = ks[e] * (1.0f + (av[e] - 1.0f) * kav[e]);
    *(LAS f32x4*)(o + 192) = t0;
    *(LAS f32x4*)(o + 256) = rs;
    *(LAS f32x4*)(o + 320) = vs;
}
__device__ __forceinline__ void scan_task(LAS unsigned char* lds, int b, int h, int half, const bf16_t* proj, const bf16_t* lora, bf16_t* yout,
                                          const float* mu, const float* kk_scale, const float* k_a, const int tid) {
    const int lane = tid & 63, w = tid >> 6;
    LAS float* ops = (LAS float*)(lds + SC_OPS); LAS float* ypart = (LAS float*)(lds + SC_YB); LAS float* cst = (LAS float*)(lds + SC_CST);
    __syncthreads();
    if (tid < 64) { cst[tid] = mu[h * 64 + tid]; cst[64 + tid] = mu[RW + h * 64 + tid]; cst[128 + tid] = mu[2 * RW + h * 64 + tid];
                    cst[192 + tid] = kk_scale[h * 64 + tid]; cst[256 + tid] = k_a[h * 64 + tid]; }
    const size_t tok0 = (size_t)b * SEQ;
    const int ht = tid - 256;
    __syncthreads();
    if (w >= 4) { scan_fill(ops, cst, ht, 0, tok0, h, proj, lora); scan_fill(ops + 16 * 384, cst, ht, 16, tok0, h, proj, lora); }
    const int kg = lane & 15, rA = (w & 3) * 8 + (lane >> 4), rB = rA + 4;
    const int vrowA = half * 32 + rA, vrowB = half * 32 + rB;
    f32x4 S = (f32x4){0.f, 0.f, 0.f, 0.f}, S2 = (f32x4){0.f, 0.f, 0.f, 0.f};
    __syncthreads();
    for (int c = 0; c < SEQ / SC_TC; ++c) {
        LAS float* opsb = ops + (c & 1) * (SC_TC * 384);
        LAS float* opsn = ops + ((c & 1) ^ 1) * (SC_TC * 384);
        for (int sub = 0; sub < 2; ++sub) {
            if (w < 4) {
                const LAS float* ob = opsb + (sub * 16) * 384 + kg * 4;
                const LAS float* vb = opsb + (sub * 16) * 384 + 320;
                f32x4 cw = *(const LAS f32x4*)(ob), cn = *(const LAS f32x4*)(ob + 64), cb = *(const LAS f32x4*)(ob + 128), ck = *(const LAS f32x4*)(ob + 192), cr = *(const LAS f32x4*)(ob + 256);
                float cvA = vb[vrowA], cvB = vb[vrowB];
                __builtin_amdgcn_s_setprio(3);
#pragma unroll 4
                for (int t16 = 0; t16 < 16; ++t16) {
                    const int tn = (t16 + 1) & 15;
                    const LAS float* nb_ = ob + tn * 384;
                    const f32x4 nw = *(const LAS f32x4*)(nb_), nn = *(const LAS f32x4*)(nb_ + 64), nb = *(const LAS f32x4*)(nb_ + 128), nk = *(const LAS f32x4*)(nb_ + 192), nr = *(const LAS f32x4*)(nb_ + 256);
                    const float nvA = vb[tn * 384 + vrowA], nvB = vb[tn * 384 + vrowB];
                    asm volatile("" ::: "memory");
                    f32x2 ta = S.lo * cn.lo; ta = S.hi * cn.hi + ta;
                    f32x2 tb = S2.lo * cn.lo; tb = S2.hi * cn.hi + tb;
                    float sa = ta.x + ta.y, sb = tb.x + tb.y;
                    sa = allsum16(sa); sb = allsum16(sb);
                    S = S * cw + (cb * sa + ck * cvA);
                    S2 = S2 * cw + (cb * sb + ck * cvB);
                    f32x2 ua = S.lo * cr.lo; ua = S.hi * cr.hi + ua;
                    f32x2 ub = S2.lo * cr.lo; ub = S2.hi * cr.hi + ub;
                    ypart[t16 * 512 + rA * 16 + kg] = ua.x + ua.y;
                    ypart[t16 * 512 + rB * 16 + kg] = ub.x + ub.y;
                    cw = nw; cn = nn; cb = nb; ck = nk; cr = nr; cvA = nvA; cvB = nvB;
                }
                __builtin_amdgcn_s_setprio(0);
            } else if (c + 1 < SEQ / SC_TC) {
                scan_fill(opsn + (sub * 16) * 384, cst, ht, (c + 1) * SC_TC + sub * 16, tok0, h, proj, lora);
            }
            __syncthreads();
            {
                const LAS float* yp_ = ypart + tid * 16;
                const f32x4 a = *(const LAS f32x4*)(yp_), b2 = *(const LAS f32x4*)(yp_ + 4), c2 = *(const LAS f32x4*)(yp_ + 8), d2 = *(const LAS f32x4*)(yp_ + 12);
                const float y = (((a[0] + a[1]) + (a[2] + a[3])) + ((b2[0] + b2[1]) + (b2[2] + b2[3]))) + (((c2[0] + c2[1]) + (c2[2] + c2[3])) + ((d2[0] + d2[1]) + (d2[2] + d2[3])));
                yout[(tok0 + c * SC_TC + sub * 16 + (tid >> 5)) * RW + h * 64 + half * 32 + (tid & 31)] = (bf16_t)(cvt_pk_bf16(y, 0.f) & 0xffffu);
            }
            __syncthreads();
        }
    }
}


__device__ __forceinline__ void conv_group(const __attribute__((address_space(4))) Params* PP, unsigned char* wreg, int l, int bits,
                                           LAS float* scr, int gw, int NGW, long gtid, long NGT, int lane) {
    const bool isA = l < 2; const int li = isA ? l : l - 2;
    if (bits & 1) {
        conv_T(PP->in[3] + (size_t)l * D * 2 * FF, D, 2 * FF, (bf16_t*)(wreg + W_FIN_PRE), PP->in[2] + l * D, 1, 0, scr, gw, NGW, lane);
        conv_T(PP->in[4] + (size_t)l * FF * D, FF, D, (bf16_t*)(wreg + W_FOUT_PRE), nullptr, 0, 0, scr, gw, NGW, lane);
    }
    if (bits & 2) {
        conv_T(PP->in[7] + (size_t)l * D * 2 * FF, D, 2 * FF, (bf16_t*)(wreg + W_FIN_POST), PP->in[6] + l * D, 1, 0, scr, gw, NGW, lane);
        conv_T(PP->in[8] + (size_t)l * FF * D, FF, D, (bf16_t*)(wreg + W_FOUT_POST), nullptr, 0, 0, scr, gw, NGW, lane);
    }
    if (bits & 4) {
        if (isA) conv_T(PP->in[13] + (size_t)li * D * AIN, D, AIN, (bf16_t*)(wreg + W_MIX_IN), PP->in[5] + l * D, 0, 0, scr, gw, NGW, lane);
        else conv_T(PP->in[26] + (size_t)li * D * D, D, D, (bf16_t*)(wreg + W_MIX_IN), PP->in[5] + l * D, 0, 0, scr, gw, NGW, lane);
    }
    if (bits & 8) {
        if (isA) conv_T(PP->in[25] + (size_t)li * D * D, D, D, (bf16_t*)(wreg + W_MIX_OUT), nullptr, 0, 0, scr, gw, NGW, lane);
        else conv_T(PP->in[28] + (size_t)li * 512 * D, 512, D, (bf16_t*)(wreg + W_MIX_OUT), nullptr, 0, 0, scr, gw, NGW, lane);
    }
    if ((bits & 16) && isA) {
        bf16_t* wl = (bf16_t*)(wreg + W_LORA);
        const float* wup = PP->in[16] + (size_t)li * 64 * RW; const float* aup = PP->in[18] + (size_t)li * 64 * RW; const float* gup = PP->in[19] + (size_t)li * 128 * RW;
        for (long i = gtid; i < (long)LORA_N * 256; i += NGT) {
            const int c = (int)(i >> 8), k = (int)(i & 255), seg = c / RW, cc = c - seg * RW; float v = 0.f;
            if (seg == 0) { if (k < 64) v = wup[k * RW + cc]; }
            else if (seg == 1) { if (k >= 64 && k < 128) v = aup[(k - 64) * RW + cc]; }
            else { if (k >= 128) v = gup[(k - 128) * RW + cc]; }
            wl[i] = (bf16_t)(cvt_pk_bf16(v, 0.f) & 0xffffu);
        }
    }
}

#define XB_TMO      128
#define XB_XCNT(j)  (256  + 64 * (j))
#define XB_XSUB(j)  (1280 + 64 * (j))
#define XB_XGEN(j)  (2304 + 64 * (j))
#define XB_TOP      3328
#define XB_TOPGEN   3392
#define XCD_BAR_WORDS 3456
#define XB_SPIN_CAP (1u << 18)
__device__ __forceinline__ unsigned xb_ld(unsigned* p)              { return __hip_atomic_load(p, __ATOMIC_RELAXED, __HIP_MEMORY_SCOPE_AGENT); }
__device__ __forceinline__ unsigned xb_add(unsigned* p, unsigned v) { return __hip_atomic_fetch_add(p, v, __ATOMIC_RELAXED, __HIP_MEMORY_SCOPE_AGENT); }
__device__ __forceinline__ unsigned xb_xcc_id() { return (unsigned)__builtin_amdgcn_s_getreg((3 << 11) | 20) & 0xFu; }
#define XB_SPIN(cond, bar) do { unsigned _sp = 0; while (cond) { __builtin_amdgcn_s_sleep(1); \
    if ((++_sp & 255u) == 0u) { if (xb_ld(&(bar)[XB_TMO])) break; if (_sp > XB_SPIN_CAP) { atomicAdd(&(bar)[XB_TMO], 1u); break; } } } } while (0)
struct XcdBarrier { unsigned* bar; unsigned x; volatile LAS unsigned* st; };
__device__ __forceinline__ XcdBarrier xcd_barrier_post(unsigned* bar, volatile LAS unsigned* st, const int tid) {
    XcdBarrier b; b.bar = bar; b.x = xb_xcc_id(); b.st = st;
    if (tid == 0) (void)xb_add(&bar[XB_XCNT(b.x)], 1u);
    return b;
}
__device__ __forceinline__ void xcd_barrier_complete(unsigned* bar, unsigned x, unsigned& nloc, unsigned& nx) {
    const unsigned G = gridDim.x * gridDim.y * gridDim.z;
    unsigned sum, cnt, mine, sp = 0u;
    for (;;) {
        sum = 0u; cnt = 0u; mine = 0u;
#pragma unroll
        for (unsigned j = 0; j < 16; ++j) { const unsigned c = xb_ld(&bar[XB_XCNT(j)]); sum += c; cnt += (c > 0u) ? 1u : 0u; mine = (j == x) ? c : mine; }
        if (sum == G) break;
        __builtin_amdgcn_s_sleep(1);
        if ((++sp & 255u) == 0u) { if (xb_ld(&bar[XB_TMO])) break; if (sp > XB_SPIN_CAP) { atomicAdd(&bar[XB_TMO], 1u); break; } }
    }
    nloc = mine > 0u ? mine : 1u; nx = cnt > 0u ? cnt : 1u;
}
__device__ __forceinline__ void xcd_barrier(const XcdBarrier& b, const int tid) {
    asm volatile("s_waitcnt vmcnt(0)" ::: "memory");
    __syncthreads();
    if (tid == 0) {
        unsigned* bar = b.bar;
        __builtin_amdgcn_s_waitcnt(0);
        unsigned nloc = b.st[0], nx = b.st[1];
        if (nloc == 0u) { xcd_barrier_complete(bar, b.x, nloc, nx); b.st[0] = nloc; b.st[1] = nx; }
        const unsigned old = xb_add(&bar[XB_XSUB(b.x)], 1u);
        const unsigned gen = old / nloc;
        if (old + 1u == (gen + 1u) * nloc) {
            __builtin_amdgcn_fence(__ATOMIC_RELEASE, "agent");
            asm volatile("s_waitcnt vmcnt(0)" ::: "memory");
            const unsigned og = xb_add(&bar[XB_TOP], 1u);
            const unsigned tg = og / nx;
            if (og + 1u == (tg + 1u) * nx) xb_add(&bar[XB_TOPGEN], 1u);
            else XB_SPIN(xb_ld(&bar[XB_TOPGEN]) == tg, bar);
            __builtin_amdgcn_fence(__ATOMIC_ACQUIRE, "agent");
            xb_add(&bar[XB_XGEN(b.x)], 1u);
            asm volatile("s_waitcnt vmcnt(0)" ::: "memory");
        } else {
            XB_SPIN(xb_ld(&bar[XB_XGEN(b.x)]) == gen, bar);
            __builtin_amdgcn_fence(__ATOMIC_ACQUIRE, "agent");
            asm volatile("s_waitcnt vmcnt(0)" ::: "memory");
        }
    }
    __syncthreads();
}

__global__ void __launch_bounds__(512, 2) fwd_kernel(Params P) {
    extern __shared__ __attribute__((aligned(16))) unsigned char lds_raw[];
    LAS unsigned char* lds = (LAS unsigned char*)lds_raw;
#if MK_SINGLE
    volatile LAS unsigned* misc = (volatile LAS unsigned*)(lds + MISC_OFF);
    if (threadIdx.x < 2) misc[threadIdx.x] = 0u;
    __syncthreads();
    (void)xcd_barrier_post((unsigned*)(P.ws + WS_BAR), misc, (int)threadIdx.x);
#endif
    const int wave_s = __builtin_amdgcn_readfirstlane((int)threadIdx.x >> 6);
    for (int it = P.ph_lo * 2; it < P.ph_hi * 2; ++it) {
        const int ph = it >> 1;
        if ((it & 1) && !((DUPMASK >> (ph % 12)) & 1)) continue;
        int tid = (wave_s << 6) | (int)__builtin_amdgcn_mbcnt_hi(~0u, __builtin_amdgcn_mbcnt_lo(~0u, 0u)); asm volatile("" : "+v"(tid));
        int bx = blockIdx.x; asm volatile("" : "+s"(bx));
        int G = gridDim.x; asm volatile("" : "+s"(G));
        const __attribute__((address_space(4))) Params* PP = (const __attribute__((address_space(4))) Params*)__builtin_amdgcn_kernarg_segment_ptr(); asm volatile("" : "+s"(PP));
        unsigned char* ws = PP->ws; float* X = PP->out;
#define lane (tid & 63)
#define wave (tid >> 6)
#define gw (bx * 8 + (tid >> 6))
#define NGW (G * 8)
#define gtid ((long)bx * 512 + tid)
#define NGT ((long)G * 512)
        float* ssq = (float*)(ws + WS_SSQ); float* memssq = (float*)(ws + WS_MEMSSQ); float* lse = (float*)(ws + WS_LSE);
        bf16_t* memb = (bf16_t*)(ws + WS_MEMB); bf16_t* memkv = (bf16_t*)(ws + WS_MEMKV);
        bf16_t* xb = (bf16_t*)(ws + WS_XB); bf16_t* yscan = xb; bf16_t* aprep = (bf16_t*)(ws + WS_XB + 48 * MiB);
        bf16_t* hbuf = (bf16_t*)(ws + WS_H); bf16_t* proj = hbuf; bf16_t* qall = hbuf; bf16_t* catb = (bf16_t*)(ws + WS_H + 64 * MiB);
        bf16_t* lora = (bf16_t*)(ws + WS_LORA); bf16_t* kvb = lora; bf16_t* og = (bf16_t*)(ws + WS_LORA + 96 * MiB); bf16_t* wmemkv = lora;
        bf16_t* cat = (bf16_t*)(ws + WS_CAT);
        unsigned char* wreg = ws + WS_W;
#define scr ((LAS float*)(lds + (tid >> 6) * 16384))
        const int l = ph / 12, p = ph % 12;
        const bool isA = l < 2; const int li = isA ? l : l - 2;
        const bool empty = (!isA && (p == 6 || p == 7)) || (p == 11 && l != 1) || (p == 0 && l != 0);
        if (empty) continue;
        if (p == 0) {
            if (l == 0) {
                for (int m = gw; m < T; m += NGW) {
                    const f32x4* xr = (const f32x4*)(PP->in[0] + (size_t)m * D) + lane; float s = 0.f;
#pragma unroll
                    for (int j = 0; j < 4; ++j) { const f32x4 v = xr[64 * j]; s += (v[0] * v[0] + v[1] * v[1]) + (v[2] * v[2] + v[3] * v[3]);
                        *((f32x4*)(X + (size_t)m * D) + lane + 64 * j) = v;
                        u32x2 o; o.x = cvt_pk_bf16(v[0], v[1]); o.y = cvt_pk_bf16(v[2], v[3]); *((u32x2*)(xb + (size_t)m * D) + lane + 64 * j) = o; }
#pragma unroll
                    for (int o = 1; o < 64; o <<= 1) s += __shfl_xor(s, o);
                    if (lane < 16) ssq[(size_t)m * 16 + lane] = (lane == 0) ? s : 0.f;
                }
                for (int m = gw; m < 2048; m += NGW) {
                    const f32x4* xr = (const f32x4*)(PP->in[1] + (size_t)m * D) + lane; float s = 0.f;
#pragma unroll
                    for (int j = 0; j < 4; ++j) { const f32x4 v = xr[64 * j]; s += (v[0] * v[0] + v[1] * v[1]) + (v[2] * v[2] + v[3] * v[3]);
                        u32x2 o; o.x = cvt_pk_bf16(v[0], v[1]); o.y = cvt_pk_bf16(v[2], v[3]); *((u32x2*)(memb + (size_t)m * D) + lane + 64 * j) = o; }
#pragma unroll
                    for (int o = 1; o < 64; o <<= 1) s += __shfl_xor(s, o);
                    if (lane < 16) memssq[(size_t)m * 16 + lane] = (lane == 0) ? s : 0.f;
                }
                for (int q = 0; q < 4; ++q)
                    conv_T(PP->in[10] + (size_t)q * D * 512, D, 512, wmemkv, PP->in[9] + q * D, 0, q * 512, scr, gw, NGW, lane);
            }
            conv_group(PP, wreg, 0, 1 | 4 | 8 | 16, scr, gw, NGW, gtid, NGT, lane);
        } else if (p == 1 || p == 2 || p == 3 || p == 5 || p == 8 || p == 9 || p == 10 || p == 11) {
            if (p == 5 && !isA) {
                if (l == 2) { conv_group(PP, wreg, 2, 2, scr, gw, NGW, gtid, NGT, lane);
                              conv_group(PP, wreg, 3, 1 | 4, scr, gw, NGW, gtid, NGT, lane); }
                if (l == 3) conv_group(PP, wreg, 3, 2, scr, gw, NGW, gtid, NGT, lane);
                for (long i0 = gtid; i0 < (long)T * 64; i0 += 4 * NGT) {
                    float l0[4], l1[4], l2[4]; u32x2 a[4], b[4], c[4];
#pragma unroll
                    for (int u = 0; u < 4; ++u) { const long i = i0 + u * NGT; const long t = i >> 6; const int hh = (int)(i >> 4) & 3, d = ((int)i & 15) * 4;
                        l0[u] = lse[t * 12 + hh]; l1[u] = lse[t * 12 + 4 + hh]; l2[u] = lse[t * 12 + 8 + hh];
                        a[u] = *(const u32x2*)(og + t * RW + hh * 64 + d); b[u] = *(const u32x2*)(og + t * RW + (4 + hh) * 64 + d); c[u] = *(const u32x2*)(og + t * RW + (8 + hh) * 64 + d); }
#pragma unroll
                    for (int u = 0; u < 4; ++u) { const long i = i0 + u * NGT; const long t = i >> 6; const int hh = (int)(i >> 4) & 3, d = ((int)i & 15) * 4;
                        const float mx = fmaxf(l0[u], fmaxf(l1[u], l2[u])); float w0 = __expf(l0[u] - mx), w1 = __expf(l1[u] - mx), w2 = __expf(l2[u] - mx);
                        const float inv = 1.0f / (w0 + w1 + w2); w0 *= inv; w1 *= inv; w2 *= inv;
                        u32x2 o; o.x = cvt_pk_bf16(w0 * bflo(a[u].x) + w1 * bflo(b[u].x) + w2 * bflo(c[u].x), w0 * bfhi(a[u].x) + w1 * bfhi(b[u].x) + w2 * bfhi(c[u].x));
                        o.y = cvt_pk_bf16(w0 * bflo(a[u].y) + w1 * bflo(b[u].y) + w2 * bflo(c[u].y), w0 * bfhi(a[u].y) + w1 * bfhi(b[u].y) + w2 * bfhi(c[u].y));
                        *(u32x2*)(catb + t * 512 + hh * 64 + d) = o; }
                }
            } else {
                if (p == 9 && l == 1)
                    conv_T(PP->in[30], D, KVW, (bf16_t*)(wreg + W_MIX_IN), PP->in[29], 0, 0, scr, gw, NGW, lane);
                if (p == 9 && l == 0) conv_group(PP, wreg, 1, 8, scr, gw, NGW, gtid, NGT, lane);
                if (p == 9 && l == 2) conv_group(PP, wreg, 3, 8, scr, gw, NGW, gtid, NGT, lane);
                if (p == 2 && l == 2) conv_group(PP, wreg, 2, 4 | 8, scr, gw, NGW, gtid, NGT, lane);
                const int nrep = (p == 3 && l == 0 && bx >= G / 2) ? 2 : 1;
                for (int rep = 0; rep < nrep; ++rep) {
                    const bf16_t* gA = xb; const bf16_t* gB = (const bf16_t*)wreg; int gM = T, gN = D, gK = D;
                    int e_mode = 2, e_perm = 1, e_ldo = 0; const float* e_ssq_in = nullptr; bf16_t* e_ob = nullptr; float e_scale = 0.f; float* e_ssq_out = nullptr;
                    const float* e_w0 = nullptr; const float* e_a0 = nullptr;
                    if (rep == 1) { gA = memb; gB = wmemkv; gM = 2048; gN = 2048; gK = D; e_ssq_in = memssq; e_ob = memkv; e_ldo = 2048; }
                    else if (p == 1) { gB = (bf16_t*)(wreg + W_FIN_PRE); gN = 2 * FF; e_mode = 0; e_ssq_in = ssq + 0; e_ob = hbuf; e_ldo = FF; }
                    else if (p == 2) { gA = hbuf; gB = (bf16_t*)(wreg + W_FOUT_PRE); gK = FF; e_mode = 1; e_perm = 0; e_scale = 0.5f; e_ob = xb; e_ssq_out = ssq + 0; }
                    else if (p == 3) { gB = (bf16_t*)(wreg + W_MIX_IN); gN = isA ? AIN : D; e_ssq_in = ssq + 0; e_ob = hbuf; e_ldo = isA ? AIN : D; }
                    else if (p == 5) { gA = aprep; gB = (bf16_t*)(wreg + W_LORA); gN = LORA_N; gK = 256; e_mode = 3; e_ob = lora; e_ldo = LORA_N; e_w0 = PP->in[15] + li * RW; e_a0 = PP->in[17] + li * RW; }
                    else if (p == 8) { gA = isA ? cat : catb; gB = (bf16_t*)(wreg + W_MIX_OUT); gK = isA ? D : 512; e_mode = 1; e_perm = 0; e_scale = 1.0f; e_ob = xb; e_ssq_out = ssq + 0; }
                    else if (p == 9) { gB = (bf16_t*)(wreg + W_FIN_POST); gN = 2 * FF; e_mode = 0; e_ssq_in = ssq + 0; e_ob = hbuf; e_ldo = FF; }
                    else if (p == 10) { gA = hbuf; gB = (bf16_t*)(wreg + W_FOUT_POST); gK = FF; e_mode = 1; e_perm = 0; e_scale = 0.5f; e_ob = xb; e_ssq_out = ssq + 0; }
                    else { gB = (bf16_t*)(wreg + W_MIX_IN); gN = KVW; e_ssq_in = ssq + 0; e_ob = kvb; e_ldo = KVW; }
                    const pg8::Gemm g{gA, gB, gM, gN, gK};
                    const pg8::Epi E{e_mode, e_perm, (const gfloat*)e_ssq_in, (gbf16*)e_ob, e_ldo, (gfloat*)X, (const gfloat*)e_w0, (const gfloat*)e_a0};
                    if (p == 9 && l == 1) { __threadfence(); }
                    pg8::StaticOrder S; if (rep == 1) S.init(g.M, g.N, G / 2, bx - G / 2); else S.init(g.M, g.N, G, bx);
                    __syncthreads();
                    int tg = tid; asm volatile("" : "+v"(tg));
                    const float e_scale_s = __int_as_float(__builtin_amdgcn_readfirstlane(__float_as_int(e_scale)));
                    pg8::gemm_phase(lds, g, S, E, e_scale_s, (gfloat*)e_ssq_out, tg);
                    __syncthreads();
                }
            }
        } else if (p == 4) {
            if (isA) {
                const float* mu = PP->in[14] + (size_t)li * 2560 + 2304;
                const int j = ((int)gtid & 63) * 4;
                const f32x4 m4 = *(const f32x4*)(mu + j);
                for (long i0 = gtid; i0 < (long)T * 64; i0 += 4 * NGT) {
                    u32x2 a[4], b[4];
#pragma unroll
                    for (int u = 0; u < 4; ++u) { const long t = (i0 + u * NGT) >> 6;
                        a[u] = *(const u32x2*)(proj + t * AIN + 2304 + j);
                        const bool hp = (t & (SEQ - 1)) != 0; const unsigned mk = hp ? 0xffffffffu : 0u; b[u] = *(const u32x2*)(proj + (t - (hp ? 1 : 0)) * AIN + 2304 + j) & mk; }
#pragma unroll
                    for (int u = 0; u < 4; ++u) { const long t = (i0 + u * NGT) >> 6;
                        float v[4]; v[0] = bflo(a[u].x) + m4[0] * (bflo(b[u].x) - bflo(a[u].x)); v[1] = bfhi(a[u].x) + m4[1] * (bfhi(b[u].x) - bfhi(a[u].x));
                        v[2] = bflo(a[u].y) + m4[2] * (bflo(b[u].y) - bflo(a[u].y)); v[3] = bfhi(a[u].y) + m4[3] * (bfhi(b[u].y) - bfhi(a[u].y));
                        if (j < 64) {
#pragma unroll
                            for (int e = 0; e < 4; ++e) v[e] = 1.0f - 2.0f * __builtin_amdgcn_rcpf(1.0f + __expf(2.0f * v[e]));
                        } else if (j >= 128) {
#pragma unroll
                            for (int e = 0; e < 4; ++e) v[e] = sigmoidf_(v[e]);
                        }
                        u32x2 o; o.x = cvt_pk_bf16(v[0], v[1]); o.y = cvt_pk_bf16(v[2], v[3]);
                        *(u32x2*)(aprep + t * 256 + j) = o; }
                }
            }
            if (!isA) {
                AttnIn r;
                { const bf16_t* Qp; const bf16_t* Kp; const bf16_t* Vp; long qs, kvs; bool ck;
                  attn_decode_B(bx, l, qall, kvb, memkv, Qp, qs, Kp, Vp, kvs, ck); attn_issue(r, Qp, qs, Kp, Vp, kvs, ck, tid); }
                for (int u = bx; u < 4096; u += G) {
                    int tidu = tid; asm volatile("" : "+v"(tidu));
                    const int un = u + G; const bool hn = un < 4096;
                    const bf16_t* nQ = qall; const bf16_t* nK = kvb; const bf16_t* nV = kvb; long nqs = 0, nkvs = 0; bool nck = false;
                    if (hn) attn_decode_B(un, l, qall, kvb, memkv, nQ, nqs, nK, nV, nkvs, nck);
                    if (u < 3072) {
                        const int blk = u & 31, hh = (u >> 5) & 3, bg = u >> 7, g = bg % 3, b = bg / 3;
                        const int dil = (g == 0) ? 1 : ((g == 1) ? 4 : 16), nper = 32 / dil, c = blk / nper, n = blk % nper, head = g * 4 + hh;
                        const long tq0 = (long)b * SEQ + (long)(n * 128) * dil + c;
                        attn_run<1>(lds, r, n > 0 ? 1 : 0, PP->in[27] + li * 64, PP->in[31], PP->in[32], dil, head, og + tq0 * RW + head * 64, (long)dil * RW, lse + tq0 * 12 + head, (long)dil * 12, tidu,
                                    hn, nQ, nqs, nK, nV, nkvs, nck);
                    } else {
                        const int um = u - 3072, head = um & 3, tb = um >> 2; const long t0 = (long)tb * 128;
                        attn_run<0>(lds, r, 1, PP->in[11] + l * 64, PP->in[12] + l * 64, nullptr, 1, 0, catb + t0 * 512 + 256 + head * 64, 512, nullptr, 0, tidu,
                                    hn, nQ, nqs, nK, nV, nkvs, nck);
                    }
                }
            }
        } else if (p == 6) {
            if (bx >= 192) {
                const int sub = bx - 192, nsub = G - 192;
                for (int um = sub; um < 1024; um += nsub) {
                    int tidu = tid; asm volatile("" : "+v"(tidu));
                    const int head = um & 3, tb = um >> 2; const long t0 = (long)tb * 128; const int b = (int)(t0 / SEQ);
                    attn_unit<0>(lds, proj + t0 * AIN + 2560 + head * 64, AIN, memkv + (size_t)(b * 256) * 2048 + l * 512 + head * 64, memkv + (size_t)(b * 256) * 2048 + l * 512 + 256 + head * 64, 2048,
                                 1, PP->in[11] + l * 64, PP->in[12] + l * 64, nullptr, 1, 0, cat + t0 * D + RW + head * 64, D, nullptr, 0, tidu);
                }
                __syncthreads();
                const int gw2 = sub * 8 + wave, NGW2 = nsub * 8; const long gtid2 = (long)sub * 512 + tid, NGT2 = (long)nsub * 512;
                conv_group(PP, wreg, l, 2, scr, gw2, NGW2, gtid2, NGT2, lane);
                conv_group(PP, wreg, l + 1, (l == 0) ? (1 | 4 | 16) : 1, scr, gw2, NGW2, gtid2, NGT2, lane);
            }
            for (int task = bx; task < 192; task += G) {
                const int half = (task >> 3) & 1, bh = (task & 7) + 8 * (task >> 4);
                const int b = bh / 12, h = bh % 12;
                scan_task(lds, b, h, half, proj, lora, yscan, PP->in[14] + (size_t)li * 2560, PP->in[20] + li * RW, PP->in[21] + li * RW, tid);
            }
        } else if (p == 7) {
            const float* mu = PP->in[14] + (size_t)li * 2560; const float* k_a = PP->in[21] + li * RW; const float* r_k = PP->in[22] + li * RW;
            const float* lng = PP->in[23] + li * RW; const float* lnb = PP->in[24] + li * RW;
            const int q3 = gw % 3, tstep = NGW / 3; const int col = q3 * 256 + lane * 4;
            const f32x4 mr = *(const f32x4*)(mu + col), mk = *(const f32x4*)(mu + RW + col), mv = *(const f32x4*)(mu + 2 * RW + col);
            const f32x4 ka = *(const f32x4*)(k_a + col), rk4 = *(const f32x4*)(r_k + col), g4 = *(const f32x4*)(lng + col), b4 = *(const f32x4*)(lnb + col);
#define POST_LOAD(T_, S) \
                const bool hp##S = ((T_) & (SEQ - 1)) != 0; \
                const u32x2 yv##S = *(const u32x2*)(yscan + (T_) * RW + col); \
                const bf16_t* pp##S = proj + (T_) * AIN + col; \
                const u32x2 rt##S = *(const u32x2*)pp##S, kt##S = *(const u32x2*)(pp##S + RW), vt##S = *(const u32x2*)(pp##S + 2 * RW); \
                const bf16_t* pq##S = pp##S - (hp##S ? AIN : 0); const unsigned msk##S = hp##S ? 0xffffffffu : 0u; \
                const u32x2 rp##S = *(const u32x2*)pq##S & msk##S, kp##S = *(const u32x2*)(pq##S + RW) & msk##S, vp##S = *(const u32x2*)(pq##S + 2 * RW) & msk##S; \
                const u32x2 av##S = *(const u32x2*)(lora + (T_) * LORA_N + RW + col), gv##S = *(const u32x2*)(lora + (T_) * LORA_N + 2 * RW + col);
#define POST_COMP(T_, S) { \
                float y[4] = {bflo(yv##S.x), bfhi(yv##S.x), bflo(yv##S.y), bfhi(yv##S.y)}; \
                const float r0[4] = {bflo(rt##S.x), bfhi(rt##S.x), bflo(rt##S.y), bfhi(rt##S.y)}, r1[4] = {bflo(rp##S.x), bfhi(rp##S.x), bflo(rp##S.y), bfhi(rp##S.y)}; \
                const float k0[4] = {bflo(kt##S.x), bfhi(kt##S.x), bflo(kt##S.y), bfhi(kt##S.y)}, k1[4] = {bflo(kp##S.x), bfhi(kp##S.x), bflo(kp##S.y), bfhi(kp##S.y)}; \
                const float v0[4] = {bflo(vt##S.x), bfhi(vt##S.x), bflo(vt##S.y), bfhi(vt##S.y)}, v1[4] = {bflo(vp##S.x), bfhi(vp##S.x), bflo(vp##S.y), bfhi(vp##S.y)}; \
                const float aa[4] = {bflo(av##S.x), bfhi(av##S.x), bflo(av##S.y), bfhi(av##S.y)}, gg[4] = {bflo(gv##S.x), bfhi(gv##S.x), bflo(gv##S.y), bfhi(gv##S.y)}; \
                float mean = allsum16((y[0] + y[1]) + (y[2] + y[3])) * (1.0f / 64.0f); \
                float var = 0.f, sb = 0.f, vs[4]; \
                _Pragma("unroll") for (int e = 0; e < 4; ++e) { y[e] -= mean; var += y[e] * y[e]; \
                    const float rs = r0[e] + mr[e] * (r1[e] - r0[e]), ks = k0[e] + mk[e] * (k1[e] - k0[e]); vs[e] = v0[e] + mv[e] * (v1[e] - v0[e]); \
                    sb += rs * ks * (1.0f + (aa[e] - 1.0f) * ka[e]) * rk4[e]; } \
                var = allsum16(var) * (1.0f / 64.0f); sb = allsum16(sb); \
                const float rstd = rsqrtf(var + 64e-5f); \
                float o[4]; \
                _Pragma("unroll") for (int e = 0; e < 4; ++e) o[e] = (y[e] * rstd * g4[e] + b4[e] + sb * vs[e]) * gg[e]; \
                u32x2 ow; ow.x = cvt_pk_bf16(o[0], o[1]); ow.y = cvt_pk_bf16(o[2], o[3]); \
                *(u32x2*)(cat + (T_) * D + col) = ow; }
            for (long t = (gw < 3 * tstep) ? gw / 3 : T; t < T; t += 2 * tstep) {
                const long tB = t + tstep; const bool hasB = tB < T; const long tBc = hasB ? tB : t;
                POST_LOAD(t, A)
                POST_LOAD(tBc, B)
                POST_COMP(t, A)
                if (hasB) POST_COMP(tB, B)
            }
#undef POST_LOAD
#undef POST_COMP
        }
#if MK_SINGLE
        if (it + 2 < P.ph_hi * 2) { if (it == 0) cg::this_grid().sync(); else { XcdBarrier xb_; xb_.bar = (unsigned*)(ws + WS_BAR); xb_.x = xb_xcc_id(); xb_.st = (volatile LAS unsigned*)(lds + MISC_OFF); xcd_barrier(xb_, tid); } }
#endif
    }
}

#undef lane
#undef wave
#undef gw
#undef NGW
#undef gtid
#undef NGT
#undef scr
extern "C" void kernel_launch(void* const* d_in, const int* in_sizes, int n_in, void* d_out, int out_size, void* d_ws, size_t ws_size, hipStream_t stream) {
    static int ready = 0;
    if (!ready) {
        if (n_in != 33 || out_size != T * D || ws_size < WS_END) { fprintf(stderr, "kernel_launch: unexpected shapes (n_in %d out %d ws %zu)\n", n_in, out_size, ws_size); ready = -1; return; }
        if (hipFuncSetAttribute((const void*)fwd_kernel, hipFuncAttributeMaxDynamicSharedMemorySize, LDS_BYTES) != hipSuccess) { fprintf(stderr, "kernel_launch: hipFuncSetAttribute failed\n"); ready = -1; return; }
        int per_cu = 0;
        hipOccupancyMaxActiveBlocksPerMultiprocessor(&per_cu, (const void*)fwd_kernel, 512, LDS_BYTES);
        if (per_cu < 1) fprintf(stderr, "kernel_launch: occupancy query says %d blocks per CU\n", per_cu);
        (void)hipGetLastError();
        ready = 1;
    }
    if (ready < 0) return;
    Params p{};
    for (int i = 0; i < 33; ++i) p.in[i] = (const float*)d_in[i];
    p.out = (float*)d_out; p.ws = (unsigned char*)d_ws;
    const int grid = 256;
#if MK_SINGLE
    hipMemsetAsync((char*)d_ws + WS_BAR, 0, 16384, stream);
    p.ph_lo = 0; p.ph_hi = 48;
    void* args[] = {&p};
    hipError_t e = hipLaunchCooperativeKernel((const void*)fwd_kernel, dim3(grid), dim3(512), args, LDS_BYTES, stream);
    if (e != hipSuccess) fprintf(stderr, "cooperative launch failed: %s\n", hipGetErrorString(e));
#else
    for (int ph = 0; ph < 48; ++ph) {
        const int l = ph / 12, q = ph % 12; const bool isA = l < 2;
        if ((!isA && (q == 6 || q == 7)) || (q == 11 && l != 1) || (q == 0 && l != 0)) continue;
        p.ph_lo = ph; p.ph_hi = ph + 1;
        hipLaunchKernelGGL(fwd_kernel, dim3(grid), dim3(512), LDS_BYTES, stream, p);
    }
#endif
}
```

```cpp
#include <hip/hip_runtime.h>
#include <hip/hip_cooperative_groups.h>
#include <cstdio>
namespace cg = cooperative_groups;

#ifndef MK_SINGLE
#define MK_SINGLE 1
#endif

#define LAS __attribute__((address_space(3)))
typedef unsigned short bf16_t;
typedef short bf16x8 __attribute__((ext_vector_type(8)));
typedef short bf16x4 __attribute__((ext_vector_type(4)));
typedef float f32x4 __attribute__((ext_vector_type(4)));
typedef float f32x2 __attribute__((ext_vector_type(2)));
typedef unsigned u32x4 __attribute__((ext_vector_type(4)));
typedef unsigned u32x2 __attribute__((ext_vector_type(2)));
#define GAS __attribute__((address_space(1)))
typedef GAS float gfloat;
typedef GAS unsigned short gbf16;

constexpr int T = 32768, D = 1024, FF = 2816, SEQ = 4096;
constexpr int AIN = 2816, RW = 768, LORA_N = 2304, KVW = 1536;
constexpr float NORM_EPS = 1e-6f;
constexpr size_t MiB = 1u << 20;
constexpr size_t WS_SSQ = 0;
constexpr size_t WS_MEMSSQ = 3584 * 1024;
constexpr size_t WS_LSE = 2 * MiB;
constexpr size_t WS_BAR = 3840 * 1024;
constexpr size_t WS_MEMB = 4 * MiB;
constexpr size_t WS_MEMKV = 8 * MiB;
constexpr size_t WS_W = 16 * MiB;
constexpr size_t WS_XB = 60 * MiB;
constexpr size_t WS_H = 124 * MiB;
constexpr size_t WS_LORA = 300 * MiB;
constexpr size_t WS_CAT = 444 * MiB;
constexpr size_t WS_END = 508 * MiB;
constexpr size_t W_FIN_PRE = 0, W_FOUT_PRE = 11 * MiB, W_FIN_POST = 16 * MiB + 512 * 1024, W_FOUT_POST = 27 * MiB + 512 * 1024,
                 W_MIX_IN = 33 * MiB, W_MIX_OUT = 38 * MiB + 512 * 1024, W_LORA = 40 * MiB + 512 * 1024;
constexpr int LDS_BYTES = 147456, MISC_OFF = 147456 - 64;
#ifndef EXP_DELAY
#define EXP_DELAY 0
#endif
#ifndef DUPMASK
#define DUPMASK 0
#endif

__device__ __forceinline__ unsigned cvt_pk_bf16(float lo, float hi) { unsigned r; asm volatile("v_cvt_pk_bf16_f32 %0, %1, %2" : "=v"(r) : "v"(lo), "v"(hi)); return r; }
__device__ __forceinline__ float bflo(unsigned u) { return __uint_as_float(u << 16); }
__device__ __forceinline__ float bfhi(unsigned u) { return __uint_as_float(u & 0xffff0000u); }
__device__ __forceinline__ float bf1(bf16_t v) { return __uint_as_float((unsigned)v << 16); }
__device__ __forceinline__ float sigmoidf_(float x) { return __builtin_amdgcn_rcpf(1.0f + __expf(-x)); }
__device__ __forceinline__ float xsum_rows(float s) {
    const auto r = __builtin_amdgcn_permlane16_swap(__float_as_uint(s), __float_as_uint(s), false, false);
    s = __uint_as_float(r[0]) + __uint_as_float(r[1]);
    const auto q = __builtin_amdgcn_permlane32_swap(__float_as_uint(s), __float_as_uint(s), false, false);
    return __uint_as_float(q[0]) + __uint_as_float(q[1]);
}
template <int CTRL> __device__ __forceinline__ float dpp_f(float v) { return __int_as_float(__builtin_amdgcn_update_dpp(0, __float_as_int(v), CTRL, 0xf, 0xf, false)); }
__device__ __forceinline__ float allsum16(float v) {
    v += dpp_f<0x128>(v);
    v += dpp_f<0x124>(v);
    v += dpp_f<0x122>(v);
    v += dpp_f<0x121>(v);
    return v;
}

namespace pg8 {
constexpr int BM = 256, BK = 64, HALF = 128, HTB = HALF * BK * 2, STAGE_BYTES = 8 * HTB, NXCD = 8, WGM = 8;
__device__ __forceinline__ int lds_byte(int r, int c) { const int st = (r >> 4) * 2 + (c >> 5), rr = r & 15, cc = c & 31, ob = rr * 64 + cc * 2; return st * 1024 + (ob ^ (((ob >> 9) & 1) << 5)); }
__device__ __forceinline__ void stage_rc(int b, int& R, int& C) { const int st = b / 1024, sb = b % 1024, swz = sb ^ (((sb >> 9) & 1) << 5); R = (st >> 1) * 16 + swz / 64; C = (st & 1) * 32 + (swz % 64) / 2; }
__device__ __forceinline__ int perm32(int rho) { const int n = rho >> 4, i = rho & 15; return 8 * (i >> 2) + 4 * n + (i & 3); }
struct Unit { int pm, pn; };
struct Gemm { const bf16_t* A; const bf16_t* Bt; int M, N, K; };
struct StaticOrder {
    int nM, nN, nwg, G, c;
    __device__ void init(int M, int N, int G_, int c_) { nM = M / BM; nN = N / BM; nwg = nM * nN; G = G_; c = c_; }
    __device__ bool next(int i, Unit& u) const {
        const long L = (long)i * G + c; if (L >= nwg) return false;
        int wgid = (int)L; { const int q = nwg / NXCD, r = nwg % NXCD, xcd = wgid % NXCD, off = wgid / NXCD; wgid = (xcd < r ? xcd * (q + 1) : r * (q + 1) + (xcd - r) * q) + off; }
        const int nig = WGM * nN, gid = wgid / nig, fm = gid * WGM, gsz = (nM - fm) < WGM ? (nM - fm) : WGM;
        u.pm = fm + ((wgid % nig) % gsz); u.pn = (wgid % nig) / gsz; return true;
    }
};

struct Epi {
    int mode, perm;
    const gfloat* ssq_in; gbf16* ob; int ldo;
    gfloat* x;
    const gfloat* w0; const gfloat* a0;
    template <int NR> __device__ __forceinline__ void rstdN(float (&rs)[NR], int rowbase, int fq) const {
        const GAS f32x4* bp = (const GAS f32x4*)(ssq_in + (size_t)rowbase * 16 + 4 * fq);
        f32x4 p[NR];
#pragma unroll
        for (int m = 0; m < NR; ++m) p[m] = bp[m * 64];
        asm volatile("" :: "v"(bp));
#pragma unroll
        for (int m = 0; m < NR; ++m) {
            float s = (p[m][0] + p[m][1]) + (p[m][2] + p[m][3]);
            s = xsum_rows(s);
            rs[m] = rsqrtf(s * (1.0f / 1024.0f) + NORM_EPS);
        }
    }
    __device__ __forceinline__ void rstd8(float (&rs)[2][4], int row0, int fq) const {
        const GAS f32x4* b0 = (const GAS f32x4*)(ssq_in + (size_t)row0 * 16 + 4 * fq);
        const GAS f32x4* b1 = (const GAS f32x4*)(ssq_in + (size_t)(row0 + HALF) * 16 + 4 * fq);
        f32x4 p[2][4];
#pragma unroll
        for (int m = 0; m < 4; ++m) { p[0][m] = b0[m * 64]; p[1][m] = b1[m * 64]; }
        asm volatile("" :: "v"(b0), "v"(b1));
#pragma unroll
        for (int ai = 0; ai < 2; ++ai)
#pragma unroll
            for (int m = 0; m < 4; ++m) {
                float s = (p[ai][m][0] + p[ai][m][1]) + (p[ai][m][2] + p[ai][m][3]);
                s = xsum_rows(s);
                rs[ai][m] = rsqrtf(s * (1.0f / 1024.0f) + NORM_EPS);
            }
    }
    __device__ __forceinline__ float row_rstd(int row, int fq) const {
        const f32x4 p = *(const GAS f32x4*)(ssq_in + (size_t)row * 16 + 4 * fq);
        float s = (p[0] + p[1]) + (p[2] + p[3]);
        s += __shfl_xor(s, 16); s += __shfl_xor(s, 32);
        return rsqrtf(s * (1.0f / 1024.0f) + NORM_EPS);
    }
    template <int KIND> __device__ __forceinline__ void epi_bf16(const f32x4 (&acc)[2][2][4][2], const Unit& u, int row0, int wc, int fq) const {
        const int colt = u.pn * BM + wc * 32 + 8 * fq;
        const int seg = (KIND == 1) ? 0 : ((KIND == 2) ? 1 : 2);
        f32x4 bv[2][2];
        if (KIND == 1 || KIND == 2) {
            const GAS f32x4* bp = (const GAS f32x4*)((KIND == 1 ? w0 : a0) + (colt - seg * RW));
            bv[0][0] = bp[0]; bv[0][1] = bp[1]; bv[1][0] = bp[32]; bv[1][1] = bp[33];
            asm volatile("" :: "v"(bp));
        }
#pragma unroll
        for (int ai = 0; ai < 2; ++ai) {
            float rsv[4] = {1.0f, 1.0f, 1.0f, 1.0f};
            if (KIND == 0) rstdN<4>(rsv, row0 + ai * HALF, fq);
#pragma unroll
            for (int m = 0; m < 4; ++m) {
                const int row = row0 + ai * HALF + m * 16;
                const float rs = rsv[m];
#pragma unroll
                for (int bj = 0; bj < 2; ++bj) {
                    const int col = colt + bj * HALF;
                    float v[8];
#pragma unroll
                    for (int n = 0; n < 2; ++n)
#pragma unroll
                        for (int j = 0; j < 4; ++j) v[n * 4 + j] = acc[ai][bj][m][n][j] * rs;
                    if (KIND == 1) {
#pragma unroll
                        for (int e = 0; e < 8; ++e) v[e] = -0.60653066f * sigmoidf_(bv[bj][e >> 2][e & 3] + v[e]);
                    } else if (KIND == 2) {
#pragma unroll
                        for (int e = 0; e < 8; ++e) v[e] = sigmoidf_(bv[bj][e >> 2][e & 3] + v[e]);
                    }
                    u32x4 w; w.x = cvt_pk_bf16(v[0], v[1]); w.y = cvt_pk_bf16(v[2], v[3]); w.z = cvt_pk_bf16(v[4], v[5]); w.w = cvt_pk_bf16(v[6], v[7]);
                    *(GAS u32x4*)(ob + (size_t)row * ldo + col) = w;
                }
            }
        }
    }
    template <int AI, int M0> __device__ __forceinline__ void epi1_pair(const f32x4 (&acc)[2][2][4][2], int row0, int col0, int fq, const float scale, gfloat* ssq_out, int slot) const {
        const int rowa = row0 + AI * HALF + M0 * 16, rowb = rowa + 16;
        GAS f32x4* xa = (GAS f32x4*)(x + (size_t)rowa * D + col0); GAS f32x4* xb_ = (GAS f32x4*)(x + (size_t)rowb * D + col0);
        f32x4 va[2][2], vb[2][2];
#pragma unroll
        for (int bj = 0; bj < 2; ++bj)
#pragma unroll
            for (int n = 0; n < 2; ++n) { va[bj][n] = xa[bj * 32 + n * 4]; vb[bj][n] = xb_[bj * 32 + n * 4]; }
        asm volatile("" :: "v"(xa), "v"(xb_));
        GAS u32x2* oa = (GAS u32x2*)(ob + (size_t)rowa * D + col0); GAS u32x2* ob2 = (GAS u32x2*)(ob + (size_t)rowb * D + col0);
        float ssa = 0.f, ssb = 0.f;
#pragma unroll
        for (int bj = 0; bj < 2; ++bj)
#pragma unroll
            for (int n = 0; n < 2; ++n) {
                const f32x4 a = va[bj][n] + acc[AI][bj][M0][n] * scale, b = vb[bj][n] + acc[AI][bj][M0 + 1][n] * scale;
                xa[bj * 32 + n * 4] = a; xb_[bj * 32 + n * 4] = b;
                u32x2 wa; wa.x = cvt_pk_bf16(a[0], a[1]); wa.y = cvt_pk_bf16(a[2], a[3]); oa[bj * 32 + n * 4] = wa;
                u32x2 wb; wb.x = cvt_pk_bf16(b[0], b[1]); wb.y = cvt_pk_bf16(b[2], b[3]); ob2[bj * 32 + n * 4] = wb;
                ssa += (a[0] * a[0] + a[1] * a[1]) + (a[2] * a[2] + a[3] * a[3]);
                ssb += (b[0] * b[0] + b[1] * b[1]) + (b[2] * b[2] + b[3] * b[3]);
            }
        ssa = xsum_rows(ssa); ssb = xsum_rows(ssb);
        if (fq == 0) { ssq_out[(size_t)rowa * 16 + slot] = ssa; ssq_out[(size_t)rowb * 16 + slot] = ssb; }
    }
    __device__ __forceinline__ void operator()(const f32x4 (&acc)[2][2][4][2], const Unit& u, int wr, int wc, int fr, int fq, const float scale, gfloat* ssq_out) const {
        const int row0 = u.pm * BM + wr * 64 + fr;
        if (mode == 0) {
            const int col0 = u.pn * 128 + wc * 32 + 8 * fq;
#pragma unroll
            for (int ai = 0; ai < 2; ++ai) {
                float rsv[4];
                rstdN<4>(rsv, row0 + ai * HALF, fq);
#pragma unroll
                for (int m = 0; m < 4; ++m) {
                    const int row = row0 + ai * HALF + m * 16;
                    const float rs = rsv[m];
                    float hv[8];
#pragma unroll
                    for (int n = 0; n < 2; ++n)
#pragma unroll
                        for (int j = 0; j < 4; ++j) { const float ag = acc[ai][0][m][n][j], au = acc[ai][1][m][n][j];
                            hv[n * 4 + j] = (ag * au) * (rs * rs) * __builtin_amdgcn_rcpf(1.0f + __builtin_amdgcn_exp2f(ag * (rs * -1.44269504f))); }
                    u32x4 w; w.x = cvt_pk_bf16(hv[0], hv[1]); w.y = cvt_pk_bf16(hv[2], hv[3]); w.z = cvt_pk_bf16(hv[4], hv[5]); w.w = cvt_pk_bf16(hv[6], hv[7]);
                    *(GAS u32x4*)(ob + (size_t)row * ldo + col0) = w;
                }
            }
        } else if (mode == 1) {
            const int col0 = u.pn * BM + wc * 32 + 4 * fq;
            epi1_pair<0, 0>(acc, row0, col0, fq, scale, ssq_out, u.pn * 4 + wc); epi1_pair<0, 2>(acc, row0, col0, fq, scale, ssq_out, u.pn * 4 + wc);
            epi1_pair<1, 0>(acc, row0, col0, fq, scale, ssq_out, u.pn * 4 + wc); epi1_pair<1, 2>(acc, row0, col0, fq, scale, ssq_out, u.pn * 4 + wc);
        } else {
            if (mode == 2) epi_bf16<0>(acc, u, row0, wc, fq);
            else { const int seg = u.pn / 3; if (seg == 0) epi_bf16<1>(acc, u, row0, wc, fq); else if (seg == 1) epi_bf16<2>(acc, u, row0, wc, fq); else epi_bf16<3>(acc, u, row0, wc, fq); }
        }
    }
};

__device__ __forceinline__ void gemm_phase(LAS unsigned char* lds, const Gemm g, const StaticOrder& S, const Epi E, const float e_scale, gfloat* e_ssq_out, const int tid) {
    const int wid = __builtin_amdgcn_readfirstlane(tid >> 6), lane = tid & 63, wr = wid >> 2, wc = wid & 3, fr = lane & 15, fq = lane >> 4;
    const int K = g.K, nt = K / BK;
    unsigned voffA[2], voffB[2];
#pragma unroll
    for (int i = 0; i < 2; ++i) { int R, C; stage_rc(tid * 16 + i * 8192, R, C); const int Rb = E.perm ? ((R & ~31) + perm32(R & 31)) : R;
        voffA[i] = (unsigned)(R * K + C) * 2u; voffB[i] = (unsigned)(Rb * K + C) * 2u; }
    const size_t kstep = (size_t)(BK * 2);
    const size_t hstep = (size_t)HALF * K * 2;
    const size_t tstep = 2 * hstep;
    const unsigned ldsw = (unsigned)wid * 1024u;
    const int aoff = lds_byte(wr * 64 + fr, fq * 8), boff = lds_byte(wc * 32 + fr, fq * 8);
#define PG8_SA(b, h) (((b) * 2 + (h)) * HTB)
#define PG8_SB(b, h) ((4 + (b) * 2 + (h)) * HTB)
#define PG8_STAGE(bufoff, gbase, voff) do { _Pragma("unroll") for (int _i = 0; _i < 2; ++_i) \
        __builtin_amdgcn_global_load_lds((const unsigned*)((const char*)(gbase) + (voff)[_i]), (LAS unsigned*)(lds + (bufoff) + ldsw + _i * 8192), 16, 0, 0); } while (0)
#define PG8_LDA(dst, b, h) do { _Pragma("unroll") for (int m = 0; m < 4; ++m) _Pragma("unroll") for (int k = 0; k < 2; ++k) dst[m][k] = *(const LAS bf16x8*)(lds + PG8_SA(b, h) + aoff + m * 2048 + k * 1024); } while (0)
#define PG8_LDB(dst, b, h) do { _Pragma("unroll") for (int n = 0; n < 2; ++n) _Pragma("unroll") for (int k = 0; k < 2; ++k) dst[n][k] = *(const LAS bf16x8*)(lds + PG8_SB(b, h) + boff + n * 2048 + k * 1024); } while (0)
#define PG8_MMA(ai, bj, At, Bt) do { __builtin_amdgcn_s_setprio(1); _Pragma("unroll") for (int m = 0; m < 4; ++m) _Pragma("unroll") for (int n = 0; n < 2; ++n) _Pragma("unroll") for (int k = 0; k < 2; ++k) \
        acc[ai][bj][m][n] = __builtin_amdgcn_mfma_f32_16x16x32_bf16(Bt[n][k], At[m][k], acc[ai][bj][m][n], 0, 0, 0); __builtin_amdgcn_s_setprio(0); } while (0)
#define PG8_WAIT_V(n) asm volatile("s_waitcnt vmcnt(" #n ")" ::: "memory")
#define PG8_WAIT_L(n) asm volatile("s_waitcnt lgkmcnt(" #n ")" ::: "memory")
#define PG8_BAR __builtin_amdgcn_s_barrier()
#define PG8_SCHED __builtin_amdgcn_sched_barrier(0)
    Unit cur, nxt; int ui = 0;
    if (!S.next(0, cur)) return;
    f32x4 acc[2][2][4][2];
#pragma unroll
    for (int a = 0; a < 2; ++a)
#pragma unroll
        for (int b = 0; b < 2; ++b)
#pragma unroll
            for (int m = 0; m < 4; ++m)
#pragma unroll
                for (int n = 0; n < 2; ++n) acc[a][b][m][n] = (f32x4){0.f, 0.f, 0.f, 0.f};
    bf16x8 At[4][2], B0[2][2], B1[2][2];
    const char* cA = (const char*)g.A + (size_t)cur.pm * tstep; const char* cB = (const char*)g.Bt + (size_t)cur.pn * tstep;
    PG8_STAGE(PG8_SB(0, 0), cB, voffB); PG8_STAGE(PG8_SA(0, 0), cA, voffA); PG8_STAGE(PG8_SB(0, 1), cB + hstep, voffB); PG8_STAGE(PG8_SA(0, 1), cA + hstep, voffA);
    if (wr == 1) PG8_BAR;
    PG8_WAIT_V(4); PG8_BAR;
    PG8_STAGE(PG8_SB(1, 0), cB + kstep, voffB); PG8_STAGE(PG8_SA(1, 0), cA + kstep, voffA); PG8_STAGE(PG8_SB(1, 1), cB + hstep + kstep, voffB);
    PG8_WAIT_V(6); PG8_BAR;
    for (;;) {
        const bool has_next = S.next(ui + 1, nxt);
        const char* nA = has_next ? (const char*)g.A + (size_t)nxt.pm * tstep : cA; const char* nB = has_next ? (const char*)g.Bt + (size_t)nxt.pn * tstep : cB;
        for (int t = 0; t < nt; t += 2) {
            const bool last = (t == nt - 2);
            const char* a1 = cA + (size_t)(t + 1) * kstep;
            const char* a2 = last ? nA : cA + (size_t)(t + 2) * kstep; const char* b2 = last ? nB : cB + (size_t)(t + 2) * kstep;
            const char* a3 = a2 + kstep; const char* b3 = b2 + kstep;
            PG8_LDB(B0, 0, 0); PG8_SCHED; PG8_LDA(At, 0, 0); PG8_STAGE(PG8_SA(1, 1), a1 + hstep, voffA);
            PG8_WAIT_L(8); PG8_BAR; PG8_WAIT_L(0); PG8_MMA(0, 0, At, B0); PG8_BAR; PG8_SCHED;
            PG8_LDB(B1, 0, 1); PG8_STAGE(PG8_SB(0, 0), b2, voffB);
            PG8_BAR; PG8_WAIT_L(0); PG8_MMA(0, 1, At, B1); PG8_BAR;
            PG8_LDA(At, 0, 1); PG8_STAGE(PG8_SA(0, 0), a2, voffA);
            PG8_BAR; PG8_WAIT_L(0); PG8_MMA(1, 0, At, B0); PG8_BAR; PG8_SCHED;
            PG8_STAGE(PG8_SB(0, 1), b2 + hstep, voffB);
            PG8_WAIT_V(6); PG8_BAR; PG8_MMA(1, 1, At, B1); PG8_BAR;
            PG8_LDB(B0, 1, 0); PG8_SCHED; PG8_LDA(At, 1, 0); PG8_STAGE(PG8_SA(0, 1), a2 + hstep, voffA);
            PG8_WAIT_L(8); PG8_BAR; PG8_WAIT_L(0); PG8_MMA(0, 0, At, B0); PG8_BAR; PG8_SCHED;
            PG8_LDB(B1, 1, 1); PG8_STAGE(PG8_SB(1, 0), b3, voffB);
            PG8_BAR; PG8_WAIT_L(0); PG8_MMA(0, 1, At, B1); PG8_BAR;
            PG8_LDA(At, 1, 1); PG8_STAGE(PG8_SA(1, 0), a3, voffA);
            PG8_BAR; PG8_WAIT_L(0); PG8_MMA(1, 0, At, B0); PG8_BAR; PG8_SCHED;
            PG8_STAGE(PG8_SB(1, 1), b3 + hstep, voffB);
            PG8_WAIT_V(6); PG8_BAR; PG8_MMA(1, 1, At, B1); PG8_BAR;
        }
        E(acc, cur, wr, wc, fr, fq, e_scale, e_ssq_out);
#if EXP_DELAY
        if (E.mode == 0) { __builtin_amdgcn_s_sleep(100); __builtin_amdgcn_s_sleep(100); }
#endif
        if (!has_next) break;
#pragma unroll
        for (int a = 0; a < 2; ++a)
#pragma unroll
            for (int b = 0; b < 2; ++b)
#pragma unroll
                for (int m = 0; m < 4; ++m)
#pragma unroll
                    for (int n = 0; n < 2; ++n) acc[a][b][m][n] = (f32x4){0.f, 0.f, 0.f, 0.f};
        cur = nxt; cA = nA; cB = nB; ++ui;
    }
    PG8_WAIT_V(0);
    if (wr == 0) PG8_BAR;
    PG8_BAR;
#undef PG8_SA
#undef PG8_SB
#undef PG8_STAGE
#undef PG8_LDA
#undef PG8_LDB
#undef PG8_MMA
#undef PG8_WAIT_V
#undef PG8_WAIT_L
#undef PG8_BAR
#undef PG8_SCHED
}
}

struct Params { const float* in[33]; float* out; unsigned char* ws; int ph_lo, ph_hi; };

__device__ __forceinline__ void conv_T(const float* W, int K, int N, bf16_t* WT, const float* gain, int swi, int row_off, LAS float* scr, int gw, int NGW, int lane) {
    const int nblk = N / 32, nitems = (K / 64) * nblk;
    f32x4 tv[8];
    if (gw < nitems) {
        const int kb = gw / nblk, nb = gw % nblk;
        const float* wp = W + (size_t)(64 * kb + (lane >> 3)) * N + 32 * nb + 4 * (lane & 7);
#pragma unroll
        for (int i = 0; i < 8; ++i) tv[i] = *(const f32x4*)(wp + (size_t)(8 * i) * N);
    }
    for (int item = gw; item < nitems; item += NGW) {
        const int kb = item / nblk, nb = item % nblk, k0 = 64 * kb, n0 = 32 * nb;
#pragma unroll
        for (int i = 0; i < 8; ++i) { LAS float* d = scr + (8 * i + (lane >> 3)) * 33 + 4 * (lane & 7); d[0] = tv[i][0]; d[1] = tv[i][1]; d[2] = tv[i][2]; d[3] = tv[i][3]; }
        if (item + NGW < nitems) {
            const int it2 = item + NGW, kb2 = it2 / nblk, nb2 = it2 % nblk;
            const float* wp = W + (size_t)(64 * kb2 + (lane >> 3)) * N + 32 * nb2 + 4 * (lane & 7);
#pragma unroll
            for (int i = 0; i < 8; ++i) tv[i] = *(const f32x4*)(wp + (size_t)(8 * i) * N);
        }
        asm volatile("s_waitcnt lgkmcnt(0)" ::: "memory");
        int drow0;
        if (swi) { const int j0 = (n0 < FF) ? n0 : n0 - FF; drow0 = 256 * (j0 >> 7) + (j0 & 127) + ((n0 < FF) ? 0 : 128); } else drow0 = row_off + n0;
        const int c = lane & 7;
        float gv[8];
#pragma unroll
        for (int e = 0; e < 8; ++e) gv[e] = gain ? gain[k0 + 8 * c + e] : 1.0f;
#pragma unroll
        for (int j = 0; j < 4; ++j) { const int n = (lane >> 3) + 8 * j; const LAS float* s = scr + (8 * c) * 33 + n;
            u32x4 o; o.x = cvt_pk_bf16(s[0 * 33] * gv[0], s[1 * 33] * gv[1]); o.y = cvt_pk_bf16(s[2 * 33] * gv[2], s[3 * 33] * gv[3]);
            o.z = cvt_pk_bf16(s[4 * 33] * gv[4], s[5 * 33] * gv[5]); o.w = cvt_pk_bf16(s[6 * 33] * gv[6], s[7 * 33] * gv[7]);
            *(u32x4*)(WT + (size_t)(drow0 + n) * K + k0 + 8 * c) = o; }
        asm volatile("s_waitcnt lgkmcnt(0)" ::: "memory");
    }
}

constexpr int KS_PITCH = 72, VT_PITCH = 272;
constexpr int AT_KS = 0, AT_VT = 256 * KS_PITCH * 2, AT_RK = AT_VT + 64 * VT_PITCH * 2, AT_TB = AT_RK + 1024;
struct AttnIn { u32x4 k[4], v[4], q0, q1; };
__device__ __forceinline__ void attn_issue_kv(AttnIn& r, const bf16_t* Kp, const bf16_t* Vp, long kv_stride, bool clampk, const int tid) {
#pragma unroll
    for (int i = 0; i < 4; ++i) {
        { const int id = tid + 512 * i, key = id >> 3, ck = id & 7; const int krow = (clampk && key < 128) ? key + 128 : key;
          r.k[i] = *(const u32x4*)(Kp + (long)krow * kv_stride + ck * 8); }
        { const int id = tid + 512 * i, key = id & 255, ck = id >> 8; const int krow = (clampk && key < 128) ? key + 128 : key;
          r.v[i] = *(const u32x4*)(Vp + (long)krow * kv_stride + ck * 8); }
    }
}
__device__ __forceinline__ void attn_issue_q(AttnIn& r, const bf16_t* Qp, long q_stride, const int tid) {
    const int lane = tid & 63, w = tid >> 6, fr = lane & 15, fq = lane >> 4;
    const int qi = 16 * w + fr;
    r.q0 = *(const u32x4*)(Qp + (long)qi * q_stride + 8 * fq); r.q1 = *(const u32x4*)(Qp + (long)qi * q_stride + 32 + 8 * fq);
}
__device__ __forceinline__ void attn_issue(AttnIn& r, const bf16_t* Qp, long q_stride, const bf16_t* Kp, const bf16_t* Vp, long kv_stride, bool clampk, const int tid) {
    attn_issue_kv(r, Kp, Vp, kv_stride, clampk, tid); attn_issue_q(r, Qp, q_stride, tid);
}
template <int MODE> __device__ __forceinline__ void attn_run(LAS unsigned char* lds, AttnIn& r,
                                          int first, const float* qg1, const float* qg2, const float* rel_bias, int dil, int head,
                                          bf16_t* Op, long o_stride, float* lsep, long lse_stride, const int tid,
                                          bool has_next, const bf16_t* nQp, long nq_stride, const bf16_t* nKp, const bf16_t* nVp, long nkv_stride, bool nclamp) {
    const int lane = tid & 63, w = tid >> 6, fr = lane & 15, fq = lane >> 4;
    LAS bf16_t* Ks = (LAS bf16_t*)(lds + AT_KS); LAS bf16_t* Vt = (LAS bf16_t*)(lds + AT_VT);
    LAS float* rk = (LAS float*)(lds + AT_RK); LAS float* tb = (LAS float*)(lds + AT_TB);
    __syncthreads();
#pragma unroll
    for (int i = 0; i < 4; ++i) {
        { const int id = tid + 512 * i, key = id >> 3, ck = id & 7;
          const u32x4 kx = r.k[i];
          *(LAS u32x4*)(Ks + key * KS_PITCH + ck * 8) = kx;
          float ss = 0.f;
#pragma unroll
          for (int e = 0; e < 4; ++e) { const float a = bflo(kx[e]), b = bfhi(kx[e]); ss += a * a + b * b; }
          ss += __shfl_xor(ss, 1); ss += __shfl_xor(ss, 2); ss += __shfl_xor(ss, 4);
          if (ck == 0) rk[key] = rsqrtf(ss * (1.0f / 64.0f) + NORM_EPS); }
        { const int id = tid + 512 * i, key = id & 255, ck = id >> 8;
          const u32x4 vx = r.v[i];
#pragma unroll
          for (int e = 0; e < 4; ++e) { Vt[(ck * 8 + 2 * e) * VT_PITCH + key] = (bf16_t)(vx[e] & 0xffffu); Vt[(ck * 8 + 2 * e + 1) * VT_PITCH + key] = (bf16_t)(vx[e] >> 16); } }
    }
    if (MODE == 1 && tid < 129) {
        const int dist = tid * dil; int bucket;
        if (dist < 16) bucket = dist;
        else { const float v = logf((float)dist / 16.0f) / 4.852030263919617f * 16.0f; int lg = 16 + (int)v; bucket = lg < 31 ? lg : 31; }
        tb[tid] = rel_bias[bucket * 12 + head];
    }
    const int qi = 16 * w + fr;
    bf16x8 Qf0, Qf1; float rq;
    {
        const u32x4 q0 = r.q0, q1 = r.q1;
        float v0[8], v1[8]; float ss = 0.f;
#pragma unroll
        for (int e = 0; e < 4; ++e) { v0[2 * e] = bflo(q0[e]); v0[2 * e + 1] = bfhi(q0[e]); v1[2 * e] = bflo(q1[e]); v1[2 * e + 1] = bfhi(q1[e]); }
#pragma unroll
        for (int e = 0; e < 8; ++e) ss += v0[e] * v0[e] + v1[e] * v1[e];
        ss += __shfl_xor(ss, 16); ss += __shfl_xor(ss, 32);
        rq = rsqrtf(ss * (1.0f / 64.0f) + NORM_EPS) * 0.125f;
#pragma unroll
        for (int e = 0; e < 8; ++e) { v0[e] *= qg1[8 * fq + e] * qg2[8 * fq + e]; v1[e] *= qg1[32 + 8 * fq + e] * qg2[32 + 8 * fq + e]; }
        u32x4 a, b;
        a.x = cvt_pk_bf16(v0[0], v0[1]); a.y = cvt_pk_bf16(v0[2], v0[3]); a.z = cvt_pk_bf16(v0[4], v0[5]); a.w = cvt_pk_bf16(v0[6], v0[7]);
        b.x = cvt_pk_bf16(v1[0], v1[1]); b.y = cvt_pk_bf16(v1[2], v1[3]); b.z = cvt_pk_bf16(v1[4], v1[5]); b.w = cvt_pk_bf16(v1[6], v1[7]);
        Qf0 = __builtin_bit_cast(bf16x8, a); Qf1 = __builtin_bit_cast(bf16x8, b);
    }
    if (has_next) attn_issue_kv(r, nKp, nVp, nkv_stride, nclamp, tid);
    __syncthreads();
    constexpr int NB = (MODE == 1) ? 9 : 16, NS = (MODE == 1) ? 10 : 16;
    f32x4 s[NS];
#pragma unroll
    for (int i = 0; i < NB; ++i) {
        const int nb = (MODE == 1) ? (w + i) : i;
        const bf16x8 ka0 = *(const LAS bf16x8*)(Ks + (16 * nb + fr) * KS_PITCH + 8 * fq), ka1 = *(const LAS bf16x8*)(Ks + (16 * nb + fr) * KS_PITCH + 32 + 8 * fq);
        f32x4 z = (f32x4){0.f, 0.f, 0.f, 0.f};
        z = __builtin_amdgcn_mfma_f32_16x16x32_bf16(ka0, Qf0, z, 0, 0, 0);
        s[i] = __builtin_amdgcn_mfma_f32_16x16x32_bf16(ka1, Qf1, z, 0, 0, 0);
    }
    if (has_next) attn_issue_q(r, nQp, nq_stride, tid);
    if (MODE == 1) s[9] = (f32x4){0.f, 0.f, 0.f, 0.f};
    float mx = -3.0e38f;
#pragma unroll
    for (int i = 0; i < NB; ++i)
#pragma unroll
        for (int j = 0; j < 4; ++j) {
            const int key = 16 * ((MODE == 1) ? (w + i) : i) + 4 * fq + j;
            float lg = s[i][j] * rq * rk[key];
            if (MODE == 1) {
                const int dsub = 128 + qi - key;
                const bool valid = (dsub >= 0) && (dsub <= 128) && (first || key >= 128);
                const int di = dsub < 0 ? 0 : (dsub > 128 ? 128 : dsub);
                lg = valid ? lg + tb[di] : -1.0e30f;
            }
            s[i][j] = lg; mx = fmaxf(mx, lg);
        }
    mx = fmaxf(mx, __shfl_xor(mx, 16)); mx = fmaxf(mx, __shfl_xor(mx, 32));
    float l = 0.f;
#pragma unroll
    for (int i = 0; i < NB; ++i)
#pragma unroll
        for (int j = 0; j < 4; ++j) { const float p = __expf(s[i][j] - mx); s[i][j] = p; l += p; }
    l += __shfl_xor(l, 16); l += __shfl_xor(l, 32);
    f32x4 o[4];
#pragma unroll
    for (int nd = 0; nd < 4; ++nd) o[nd] = (f32x4){0.f, 0.f, 0.f, 0.f};
#pragma unroll
    for (int kb = 0; kb < NS / 2; ++kb) {
        u32x4 pa; pa.x = cvt_pk_bf16(s[2 * kb][0], s[2 * kb][1]); pa.y = cvt_pk_bf16(s[2 * kb][2], s[2 * kb][3]);
        pa.z = cvt_pk_bf16(s[2 * kb + 1][0], s[2 * kb + 1][1]); pa.w = cvt_pk_bf16(s[2 * kb + 1][2], s[2 * kb + 1][3]);
        const bf16x8 pf = __builtin_bit_cast(bf16x8, pa);
        int k0 = 32 * kb, k1 = 32 * kb + 16;
        if (MODE == 1) { k0 = 16 * (w + 2 * kb); const int b1 = w + 2 * kb + 1; k1 = 16 * (b1 > 15 ? 15 : b1); }
#pragma unroll
        for (int nd = 0; nd < 4; ++nd) {
            const LAS bf16_t* vp = Vt + (16 * nd + fr) * VT_PITCH + 4 * fq;
            const u32x2 v0 = *(const LAS u32x2*)(vp + k0), v1 = *(const LAS u32x2*)(vp + k1);
            u32x4 vb; vb.x = v0.x; vb.y = v0.y; vb.z = v1.x; vb.w = v1.y;
            o[nd] = __builtin_amdgcn_mfma_f32_16x16x32_bf16(pf, __builtin_bit_cast(bf16x8, vb), o[nd], 0, 0, 0);
        }
    }
    const float linv = 1.0f / l;
#pragma unroll
    for (int j = 0; j < 4; ++j) {
        const float li = __shfl(linv, 4 * fq + j);
        bf16_t* orow = Op + (long)(16 * w + 4 * fq + j) * o_stride;
#pragma unroll
        for (int nd = 0; nd < 4; ++nd) orow[16 * nd + fr] = (bf16_t)(cvt_pk_bf16(o[nd][j] * li, 0.f) & 0xffffu);
    }
    if (MODE == 1 && fq == 0) lsep[(long)qi * lse_stride] = mx + logf(l);
}
template <int MODE> __device__ __forceinline__ void attn_unit(LAS unsigned char* lds, const bf16_t* Qp, long q_stride, const bf16_t* Kp, const bf16_t* Vp, long kv_stride,
                                          int first, const float* qg1, const float* qg2, const float* rel_bias, int dil, int head,
                                          bf16_t* Op, long o_stride, float* lsep, long lse_stride, const int tid) {
    AttnIn r;
    attn_issue(r, Qp, q_stride, Kp, Vp, kv_stride, (MODE == 1) && !first, tid);
    attn_run<MODE>(lds, r, first, qg1, qg2, rel_bias, dil, head, Op, o_stride, lsep, lse_stride, tid, false, nullptr, 0, nullptr, nullptr, 0, false);
}
__device__ __forceinline__ void attn_decode_B(int u, int l, const bf16_t* qall, const bf16_t* kvb, const bf16_t* memkv,
                                              const bf16_t*& Qp, long& qs, const bf16_t*& Kp, const bf16_t*& Vp, long& kvs, bool& clampk) {
    if (u < 3072) {
        const int blk = u & 31, hh = (u >> 5) & 3, bg = u >> 7, g = bg % 3, b = bg / 3;
        const int dil = (g == 0) ? 1 : ((g == 1) ? 4 : 16), nper = 32 / dil, c = blk / nper, n = blk % nper, head = g * 4 + hh;
        const long tq0 = (long)b * SEQ + (long)(n * 128) * dil + c, tk0 = tq0 - 128L * dil;
        Qp = qall + tq0 * D + head * 64; qs = (long)dil * D; Kp = kvb + tk0 * KVW + head * 64; Vp = Kp + RW; kvs = (long)dil * KVW; clampk = (n == 0);
    } else {
        const int um = u - 3072, head = um & 3, tb = um >> 2; const long t0 = (long)tb * 128; const int b = (int)(t0 / SEQ);
        Qp = qall + t0 * D + RW + head * 64; qs = D; Kp = memkv + (size_t)(b * 256) * 2048 + l * 512 + head * 64; Vp = Kp + 256; kvs = 2048; clampk = false;
    }
}

constexpr int SC_TC = 32;
constexpr int SC_OPS = 0, SC_YB = 2 * SC_TC * 384 * 4, SC_CST = SC_YB + 16 * 512 * 4;
__device__ __forceinline__ void scan_fill(LAS float* opsd, const LAS float* cst, int ht, int tpos0, size_t tok0, int h, const bf16_t* proj, const bf16_t* lora) {
    const int htt = ht >> 4, hch = (ht & 15) * 4;
    const int tpos = tpos0 + htt; const size_t t_ = tok0 + tpos; const bool hp = tpos > 0;
    const bf16_t* p_ = proj + t_ * AIN + h * 64 + hch; const bf16_t* pq_ = p_ - (hp ? AIN : 0); const unsigned mk_ = hp ? 0xffffffffu : 0u;
    const u32x2 r_t = *(const u32x2*)p_, k_t = *(const u32x2*)(p_ + RW), v_t = *(const u32x2*)(p_ + 2 * RW);
    const u32x2 r_p = *(const u32x2*)pq_ & mk_, k_p = *(const u32x2*)(pq_ + RW) & mk_, v_p = *(const u32x2*)(pq_ + 2 * RW) & mk_;
    const bf16_t* l_ = lora + t_ * LORA_N + h * 64 + hch;
    const u32x2 pw = *(const u32x2*)l_, pa = *(const u32x2*)(l_ + RW);
    const f32x4 mur = *(const LAS f32x4*)(cst + hch), muk = *(const LAS f32x4*)(cst + 64 + hch), muv = *(const LAS f32x4*)(cst + 128 + hch),
                kks = *(const LAS f32x4*)(cst + 192 + hch), kav = *(const LAS f32x4*)(cst + 256 + hch);
    f32x4 rs, ks, vs, wv, av, kr; float ss = 0.f;
#pragma unroll
    for (int e = 0; e < 4; ++e) {
        const unsigned sh = e >> 1; const bool hi = e & 1;
        const float rt = hi ? bfhi(r_t[sh]) : bflo(r_t[sh]), rp = hi ? bfhi(r_p[sh]) : bflo(r_p[sh]);
        const float kt = hi ? bfhi(k_t[sh]) : bflo(k_t[sh]), kp = hi ? bfhi(k_p[sh]) : bflo(k_p[sh]);
        const float vt = hi ? bfhi(v_t[sh]) : bflo(v_t[sh]), vp = hi ? bfhi(v_p[sh]) : bflo(v_p[sh]);
        rs[e] = rt + mur[e] * (rp - rt); ks[e] = kt + muk[e] * (kp - kt); vs[e] = vt + muv[e] * (vp - vt);
        wv[e] = __expf(hi ? bfhi(pw[sh]) : bflo(pw[sh])); av[e] = hi ? bfhi(pa[sh]) : bflo(pa[sh]);
        kr[e] = ks[e] * kks[e]; ss += kr[e] * kr[e];
    }
    ss = allsum16(ss);
    const float inv = 1.0f / fmaxf(sqrtf(ss), 1e-12f);
    LAS float* o = opsd + htt * 384 + hch;
    f32x4 t0;
    *(LAS f32x4*)(o) = wv;
    t0 = kr * (-inv); *(LAS f32x4*)(o + 64) = t0;
    t0 = kr * inv * av; *(LAS f32x4*)(o + 128) = t0;
#pragma unroll
    for (int e = 0; e < 4; ++e) t0[e] = ks[e] * (1.0f + (av[e] - 1.0f) * kav[e]);
    *(LAS f32x4*)(o + 192) = t0;
    *(LAS f32x4*)(o + 256) = rs;
    *(LAS f32x4*)(o + 320) = vs;
}
__device__ __forceinline__ void scan_task(LAS unsigned char* lds, int b, int h, int half, const bf16_t* proj, const bf16_t* lora, bf16_t* yout,
                                          const float* mu, const float* kk_scale, const float* k_a, const int tid) {
    const int lane = tid & 63, w = tid >> 6;
    LAS float* ops = (LAS float*)(lds + SC_OPS); LAS float* ypart = (LAS float*)(lds + SC_YB); LAS float* cst = (LAS float*)(lds + SC_CST);
    __syncthreads();
    if (tid < 64) { cst[tid] = mu[h * 64 + tid]; cst[64 + tid] = mu[RW + h * 64 + tid]; cst[128 + tid] = mu[2 * RW + h * 64 + tid];
                    cst[192 + tid] = kk_scale[h * 64 + tid]; cst[256 + tid] = k_a[h * 64 + tid]; }
    const size_t tok0 = (size_t)b * SEQ;
    const int ht = tid - 256;
    __syncthreads();
    if (w >= 4) { scan_fill(ops, cst, ht, 0, tok0, h, proj, lora); scan_fill(ops + 16 * 384, cst, ht, 16, tok0, h, proj, lora); }
    const int kg = lane & 15, rA = (w & 3) * 8 + (lane >> 4), rB = rA + 4;
    const int vrowA = half * 32 + rA, vrowB = half * 32 + rB;
    f32x4 S = (f32x4){0.f, 0.f, 0.f, 0.f}, S2 = (f32x4){0.f, 0.f, 0.f, 0.f};
    __syncthreads();
    for (int c = 0; c < SEQ / SC_TC; ++c) {
        LAS float* opsb = ops + (c & 1) * (SC_TC * 384);
        LAS float* opsn = ops + ((c & 1) ^ 1) * (SC_TC * 384);
        for (int sub = 0; sub < 2; ++sub) {
            if (w < 4) {
                const LAS float* ob = opsb + (sub * 16) * 384 + kg * 4;
                const LAS float* vb = opsb + (sub * 16) * 384 + 320;
                f32x4 cw = *(const LAS f32x4*)(ob), cn = *(const LAS f32x4*)(ob + 64), cb = *(const LAS f32x4*)(ob + 128), ck = *(const LAS f32x4*)(ob + 192), cr = *(const LAS f32x4*)(ob + 256);
                float cvA = vb[vrowA], cvB = vb[vrowB];
                __builtin_amdgcn_s_setprio(3);
#pragma unroll 4
                for (int t16 = 0; t16 < 16; ++t16) {
                    const int tn = (t16 + 1) & 15;
                    const LAS float* nb_ = ob + tn * 384;
                    const f32x4 nw = *(const LAS f32x4*)(nb_), nn = *(const LAS f32x4*)(nb_ + 64), nb = *(const LAS f32x4*)(nb_ + 128), nk = *(const LAS f32x4*)(nb_ + 192), nr = *(const LAS f32x4*)(nb_ + 256);
                    const float nvA = vb[tn * 384 + vrowA], nvB = vb[tn * 384 + vrowB];
                    asm volatile("" ::: "memory");
                    f32x2 ta = S.lo * cn.lo; ta = S.hi * cn.hi + ta;
                    f32x2 tb = S2.lo * cn.lo; tb = S2.hi * cn.hi + tb;
                    float sa = ta.x + ta.y, sb = tb.x + tb.y;
                    sa = allsum16(sa); sb = allsum16(sb);
                    S = S * cw + (cb * sa + ck * cvA);
                    S2 = S2 * cw + (cb * sb + ck * cvB);
                    f32x2 ua = S.lo * cr.lo; ua = S.hi * cr.hi + ua;
                    f32x2 ub = S2.lo * cr.lo; ub = S2.hi * cr.hi + ub;
                    ypart[t16 * 512 + rA * 16 + kg] = ua.x + ua.y;
                    ypart[t16 * 512 + rB * 16 + kg] = ub.x + ub.y;
                    cw = nw; cn = nn; cb = nb; ck = nk; cr = nr; cvA = nvA; cvB = nvB;
                }
                __builtin_amdgcn_s_setprio(0);
            } else if (c + 1 < SEQ / SC_TC) {
                scan_fill(opsn + (sub * 16) * 384, cst, ht, (c + 1) * SC_TC + sub * 16, tok0, h, proj, lora);
            }
            __syncthreads();
            {
                const LAS float* yp_ = ypart + tid * 16;
                const f32x4 a = *(const LAS f32x4*)(yp_), b2 = *(const LAS f32x4*)(yp_ + 4), c2 = *(const LAS f32x4*)(yp_ + 8), d2 = *(const LAS f32x4*)(yp_ + 12);
                const float y = (((a[0] + a[1]) + (a[2] + a[3])) + ((b2[0] + b2[1]) + (b2[2] + b2[3]))) + (((c2[0] + c2[1]) + (c2[2] + c2[3])) + ((d2[0] + d2[1]) + (d2[2] + d2[3])));
                yout[(tok0 + c * SC_TC + sub * 16 + (tid >> 5)) * RW + h * 64 + half * 32 + (tid & 31)] = (bf16_t)(cvt_pk_bf16(y, 0.f) & 0xffffu);
            }
            __syncthreads();
        }
    }
}


__device__ __forceinline__ void conv_group(const __attribute__((address_space(4))) Params* PP, unsigned char* wreg, int l, int bits,
                                           LAS float* scr, int gw, int NGW, long gtid, long NGT, int lane) {
    const bool isA = l < 2; const int li = isA ? l : l - 2;
    if (bits & 1) {
        conv_T(PP->in[3] + (size_t)l * D * 2 * FF, D, 2 * FF, (bf16_t*)(wreg + W_FIN_PRE), PP->in[2] + l * D, 1, 0, scr, gw, NGW, lane);
        conv_T(PP->in[4] + (size_t)l * FF * D, FF, D, (bf16_t*)(wreg + W_FOUT_PRE), nullptr, 0, 0, scr, gw, NGW, lane);
    }
    if (bits & 2) {
        conv_T(PP->in[7] + (size_t)l * D * 2 * FF, D, 2 * FF, (bf16_t*)(wreg + W_FIN_POST), PP->in[6] + l * D, 1, 0, scr, gw, NGW, lane);
        conv_T(PP->in[8] + (size_t)l * FF * D, FF, D, (bf16_t*)(wreg + W_FOUT_POST), nullptr, 0, 0, scr, gw, NGW, lane);
    }
    if (bits & 4) {
        if (isA) conv_T(PP->in[13] + (size_t)li * D * AIN, D, AIN, (bf16_t*)(wreg + W_MIX_IN), PP->in[5] + l * D, 0, 0, scr, gw, NGW, lane);
        else conv_T(PP->in[26] + (size_t)li * D * D, D, D, (bf16_t*)(wreg + W_MIX_IN), PP->in[5] + l * D, 0, 0, scr, gw, NGW, lane);
    }
    if (bits & 8) {
        if (isA) conv_T(PP->in[25] + (size_t)li * D * D, D, D, (bf16_t*)(wreg + W_MIX_OUT), nullptr, 0, 0, scr, gw, NGW, lane);
        else conv_T(PP->in[28] + (size_t)li * 512 * D, 512, D, (bf16_t*)(wreg + W_MIX_OUT), nullptr, 0, 0, scr, gw, NGW, lane);
    }
    if ((bits & 16) && isA) {
        bf16_t* wl = (bf16_t*)(wreg + W_LORA);
        const float* wup = PP->in[16] + (size_t)li * 64 * RW; const float* aup = PP->in[18] + (size_t)li * 64 * RW; const float* gup = PP->in[19] + (size_t)li * 128 * RW;
        for (long i = gtid; i < (long)LORA_N * 256; i += NGT) {
            const int c = (int)(i >> 8), k = (int)(i & 255), seg = c / RW, cc = c - seg * RW; float v = 0.f;
            if (seg == 0) { if (k < 64) v = wup[k * RW + cc]; }
            else if (seg == 1) { if (k >= 64 && k < 128) v = aup[(k - 64) * RW + cc]; }
            else { if (k >= 128) v = gup[(k - 128) * RW + cc]; }
            wl[i] = (bf16_t)(cvt_pk_bf16(v, 0.f) & 0xffffu);
        }
    }
}

#define XB_TMO      128
#define XB_XCNT(j)  (256  + 64 * (j))
#define XB_XSUB(j)  (1280 + 64 * (j))
#define XB_XGEN(j)  (2304 + 64 * (j))
#define XB_TOP      3328
#define XB_TOPGEN   3392
#define XCD_BAR_WORDS 3456
#define XB_SPIN_CAP (1u << 18)
__device__ __forceinline__ unsigned xb_ld(unsigned* p)              { return __hip_atomic_load(p, __ATOMIC_RELAXED, __HIP_MEMORY_SCOPE_AGENT); }
__device__ __forceinline__ unsigned xb_add(unsigned* p, unsigned v) { return __hip_atomic_fetch_add(p, v, __ATOMIC_RELAXED, __HIP_MEMORY_SCOPE_AGENT); }
__device__ __forceinline__ unsigned xb_xcc_id() { return (unsigned)__builtin_amdgcn_s_getreg((3 << 11) | 20) & 0xFu; }
#define XB_SPIN(cond, bar) do { unsigned _sp = 0; while (cond) { __builtin_amdgcn_s_sleep(1); \
    if ((++_sp & 255u) == 0u) { if (xb_ld(&(bar)[XB_TMO])) break; if (_sp > XB_SPIN_CAP) { atomicAdd(&(bar)[XB_TMO], 1u); break; } } } } while (0)
struct XcdBarrier { unsigned* bar; unsigned x; volatile LAS unsigned* st; };
__device__ __forceinline__ XcdBarrier xcd_barrier_post(unsigned* bar, volatile LAS unsigned* st, const int tid) {
    XcdBarrier b; b.bar = bar; b.x = xb_xcc_id(); b.st = st;
    if (tid == 0) (void)xb_add(&bar[XB_XCNT(b.x)], 1u);
    return b;
}
__device__ __forceinline__ void xcd_barrier_complete(unsigned* bar, unsigned x, unsigned& nloc, unsigned& nx) {
    const unsigned G = gridDim.x * gridDim.y * gridDim.z;
    unsigned sum, cnt, mine, sp = 0u;
    for (;;) {
        sum = 0u; cnt = 0u; mine = 0u;
#pragma unroll
        for (unsigned j = 0; j < 16; ++j) { const unsigned c = xb_ld(&bar[XB_XCNT(j)]); sum += c; cnt += (c > 0u) ? 1u : 0u; mine = (j == x) ? c : mine; }
        if (sum == G) break;
        __builtin_amdgcn_s_sleep(1);
        if ((++sp & 255u) == 0u) { if (xb_ld(&bar[XB_TMO])) break; if (sp > XB_SPIN_CAP) { atomicAdd(&bar[XB_TMO], 1u); break; } }
    }
    nloc = mine > 0u ? mine : 1u; nx = cnt > 0u ? cnt : 1u;
}
__device__ __forceinline__ void xcd_barrier(const XcdBarrier& b, const int tid) {
    asm volatile("s_waitcnt vmcnt(0)" ::: "memory");
    __syncthreads();
    if (tid == 0) {
        unsigned* bar = b.bar;
        __builtin_amdgcn_s_waitcnt(0);
        unsigned nloc = b.st[0], nx = b.st[1];
        if (nloc == 0u) { xcd_barrier_complete(bar, b.x, nloc, nx); b.st[0] = nloc; b.st[1] = nx; }
        const unsigned old = xb_add(&bar[XB_XSUB(b.x)], 1u);
        const unsigned gen = old / nloc;
        if (old + 1u == (gen + 1u) * nloc) {
            __builtin_amdgcn_fence(__ATOMIC_RELEASE, "agent");
            asm volatile("s_waitcnt vmcnt(0)" ::: "memory");
            const unsigned og = xb_add(&bar[XB_TOP], 1u);
            const unsigned tg = og / nx;
            if (og + 1u == (tg + 1u) * nx) xb_add(&bar[XB_TOPGEN], 1u);
            else XB_SPIN(xb_ld(&bar[XB_TOPGEN]) == tg, bar);
            __builtin_amdgcn_fence(__ATOMIC_ACQUIRE, "agent");
            xb_add(&bar[XB_XGEN(b.x)], 1u);
            asm volatile("s_waitcnt vmcnt(0)" ::: "memory");
        } else {
            XB_SPIN(xb_ld(&bar[XB_XGEN(b.x)]) == gen, bar);
            __builtin_amdgcn_fence(__ATOMIC_ACQUIRE, "agent");
            asm volatile("s_waitcnt vmcnt(0)" ::: "memory");
        }
    }
    __syncthreads();
}

__global__ void __launch_bounds__(512, 2) fwd_kernel(Params P) {
    extern __shared__ __attribute__((aligned(16))) unsigned char lds_raw[];
    LAS unsigned char* lds = (LAS unsigned char*)lds_raw;
#if MK_SINGLE
    volatile LAS unsigned* misc = (volatile LAS unsigned*)(lds + MISC_OFF);
    if (threadIdx.x < 2) misc[threadIdx.x] = 0u;
    __syncthreads();
    (void)xcd_barrier_post((unsigned*)(P.ws + WS_BAR), misc, (int)threadIdx.x);
#endif
    const int wave_s = __builtin_amdgcn_readfirstlane((int)threadIdx.x >> 6);
    for (int it = P.ph_lo * 2; it < P.ph_hi * 2; ++it) {
        const int ph = it >> 1;
        if ((it & 1) && !((DUPMASK >> (ph % 12)) & 1)) continue;
        int tid = (wave_s << 6) | (int)__builtin_amdgcn_mbcnt_hi(~0u, __builtin_amdgcn_mbcnt_lo(~0u, 0u)); asm volatile("" : "+v"(tid));
        int bx = blockIdx.x; asm volatile("" : "+s"(bx));
        int G = gridDim.x; asm volatile("" : "+s"(G));
        const __attribute__((address_space(4))) Params* PP = (const __attribute__((address_space(4))) Params*)__builtin_amdgcn_kernarg_segment_ptr(); asm volatile("" : "+s"(PP));
        unsigned char* ws = PP->ws; float* X = PP->out;
#define lane (tid & 63)
#define wave (tid >> 6)
#define gw (bx * 8 + (tid >> 6))
#define NGW (G * 8)
#define gtid ((long)bx * 512 + tid)
#define NGT ((long)G * 512)
        float* ssq = (float*)(ws + WS_SSQ); float* memssq = (float*)(ws + WS_MEMSSQ); float* lse = (float*)(ws + WS_LSE);
        bf16_t* memb = (bf16_t*)(ws + WS_MEMB); bf16_t* memkv = (bf16_t*)(ws + WS_MEMKV);
        bf16_t* xb = (bf16_t*)(ws + WS_XB); bf16_t* yscan = xb; bf16_t* aprep = (bf16_t*)(ws + WS_XB + 48 * MiB);
        bf16_t* hbuf = (bf16_t*)(ws + WS_H); bf16_t* proj = hbuf; bf16_t* qall = hbuf; bf16_t* catb = (bf16_t*)(ws + WS_H + 64 * MiB);
        bf16_t* lora = (bf16_t*)(ws + WS_LORA); bf16_t* kvb = lora; bf16_t* og = (bf16_t*)(ws + WS_LORA + 96 * MiB); bf16_t* wmemkv = lora;
        bf16_t* cat = (bf16_t*)(ws + WS_CAT);
        unsigned char* wreg = ws + WS_W;
#define scr ((LAS float*)(lds + (tid >> 6) * 16384))
        const int l = ph / 12, p = ph % 12;
        const bool isA = l < 2; const int li = isA ? l : l - 2;
        const bool empty = (!isA && (p == 6 || p == 7)) || (p == 11 && l != 1) || (p == 0 && l != 0);
        if (empty) continue;
        if (p == 0) {
            if (l == 0) {
                for (int m = gw; m < T; m += NGW) {
                    const f32x4* xr = (const f32x4*)(PP->in[0] + (size_t)m * D) + lane; float s = 0.f;
#pragma unroll
                    for (int j = 0; j < 4; ++j) { const f32x4 v = xr[64 * j]; s += (v[0] * v[0] + v[1] * v[1]) + (v[2] * v[2] + v[3] * v[3]);
                        *((f32x4*)(X + (size_t)m * D) + lane + 64 * j) = v;
                        u32x2 o; o.x = cvt_pk_bf16(v[0], v[1]); o.y = cvt_pk_bf16(v[2], v[3]); *((u32x2*)(xb + (size_t)m * D) + lane + 64 * j) = o; }
#pragma unroll
                    for (int o = 1; o < 64; o <<= 1) s += __shfl_xor(s, o);
                    if (lane < 16) ssq[(size_t)m * 16 + lane] = (lane == 0) ? s : 0.f;
                }
                for (int m = gw; m < 2048; m += NGW) {
                    const f32x4* xr = (const f32x4*)(PP->in[1] + (size_t)m * D) + lane; float s = 0.f;
#pragma unroll
                    for (int j = 0; j < 4; ++j) { const f32x4 v = xr[64 * j]; s += (v[0] * v[0] + v[1] * v[1]) + (v[2] * v[2] + v[3] * v[3]);
                        u32x2 o; o.x = cvt_pk_bf16(v[0], v[1]); o.y = cvt_pk_bf16(v[2], v[3]); *((u32x2*)(memb + (size_t)m * D) + lane + 64 * j) = o; }
#pragma unroll
                    for (int o = 1; o < 64; o <<= 1) s += __shfl_xor(s, o);
                    if (lane < 16) memssq[(size_t)m * 16 + lane] = (lane == 0) ? s : 0.f;
                }
                for (int q = 0; q < 4; ++q)
                    conv_T(PP->in[10] + (size_t)q * D * 512, D, 512, wmemkv, PP->in[9] + q * D, 0, q * 512, scr, gw, NGW, lane);
            }
            conv_group(PP, wreg, 0, 1 | 4 | 8 | 16, scr, gw, NGW, gtid, NGT, lane);
        } else if (p == 1 || p == 2 || p == 3 || p == 5 || p == 8 || p == 9 || p == 10 || p == 11) {
            if (p == 5 && !isA) {
                if (l == 2) { conv_group(PP, wreg, 2, 2, scr, gw, NGW, gtid, NGT, lane);
                              conv_group(PP, wreg, 3, 1 | 4, scr, gw, NGW, gtid, NGT, lane); }
                if (l == 3) conv_group(PP, wreg, 3, 2, scr, gw, NGW, gtid, NGT, lane);
                for (long i0 = gtid; i0 < (long)T * 64; i0 += 4 * NGT) {
                    float l0[4], l1[4], l2[4]; u32x2 a[4], b[4], c[4];
#pragma unroll
                    for (int u = 0; u < 4; ++u) { const long i = i0 + u * NGT; const long t = i >> 6; const int hh = (int)(i >> 4) & 3, d = ((int)i & 15) * 4;
                        l0[u] = lse[t * 12 + hh]; l1[u] = lse[t * 12 + 4 + hh]; l2[u] = lse[t * 12 + 8 + hh];
                        a[u] = *(const u32x2*)(og + t * RW + hh * 64 + d); b[u] = *(const u32x2*)(og + t * RW + (4 + hh) * 64 + d); c[u] = *(const u32x2*)(og + t * RW + (8 + hh) * 64 + d); }
#pragma unroll
                    for (int u = 0; u < 4; ++u) { const long i = i0 + u * NGT; const long t = i >> 6; const int hh = (int)(i >> 4) & 3, d = ((int)i & 15) * 4;
                        const float mx = fmaxf(l0[u], fmaxf(l1[u], l2[u])); float w0 = __expf(l0[u] - mx), w1 = __expf(l1[u] - mx), w2 = __expf(l2[u] - mx);
                        const float inv = 1.0f / (w0 + w1 + w2); w0 *= inv; w1 *= inv; w2 *= inv;
                        u32x2 o; o.x = cvt_pk_bf16(w0 * bflo(a[u].x) + w1 * bflo(b[u].x) + w2 * bflo(c[u].x), w0 * bfhi(a[u].x) + w1 * bfhi(b[u].x) + w2 * bfhi(c[u].x));
                        o.y = cvt_pk_bf16(w0 * bflo(a[u].y) + w1 * bflo(b[u].y) + w2 * bflo(c[u].y), w0 * bfhi(a[u].y) + w1 * bfhi(b[u].y) + w2 * bfhi(c[u].y));
                        *(u32x2*)(catb + t * 512 + hh * 64 + d) = o; }
                }
            } else {
                if (p == 9 && l == 1)
                    conv_T(PP->in[30], D, KVW, (bf16_t*)(wreg + W_MIX_IN), PP->in[29], 0, 0, scr, gw, NGW, lane);
                if (p == 9 && l == 0) conv_group(PP, wreg, 1, 8, scr, gw, NGW, gtid, NGT, lane);
                if (p == 9 && l == 2) conv_group(PP, wreg, 3, 8, scr, gw, NGW, gtid, NGT, lane);
                if (p == 2 && l == 2) conv_group(PP, wreg, 2, 4 | 8, scr, gw, NGW, gtid, NGT, lane);
                const int nrep = (p == 3 && l == 0 && bx >= G / 2) ? 2 : 1;
                for (int rep = 0; rep < nrep; ++rep) {
                    const bf16_t* gA = xb; const bf16_t* gB = (const bf16_t*)wreg; int gM = T, gN = D, gK = D;
                    int e_mode = 2, e_perm = 1, e_ldo = 0; const float* e_ssq_in = nullptr; bf16_t* e_ob = nullptr; float e_scale = 0.f; float* e_ssq_out = nullptr;
                    const float* e_w0 = nullptr; const float* e_a0 = nullptr;
                    if (rep == 1) { gA = memb; gB = wmemkv; gM = 2048; gN = 2048; gK = D; e_ssq_in = memssq; e_ob = memkv; e_ldo = 2048; }
                    else if (p == 1) { gB = (bf16_t*)(wreg + W_FIN_PRE); gN = 2 * FF; e_mode = 0; e_ssq_in = ssq + 0; e_ob = hbuf; e_ldo = FF; }
                    else if (p == 2) { gA = hbuf; gB = (bf16_t*)(wreg + W_FOUT_PRE); gK = FF; e_mode = 1; e_perm = 0; e_scale = 0.5f; e_ob = xb; e_ssq_out = ssq + 0; }
                    else if (p == 3) { gB = (bf16_t*)(wreg + W_MIX_IN); gN = isA ? AIN : D; e_ssq_in = ssq + 0; e_ob = hbuf; e_ldo = isA ? AIN : D; }
                    else if (p == 5) { gA = aprep; gB = (bf16_t*)(wreg + W_LORA); gN = LORA_N; gK = 256; e_mode = 3; e_ob = lora; e_ldo = LORA_N; e_w0 = PP->in[15] + li * RW; e_a0 = PP->in[17] + li * RW; }
                    else if (p == 8) { gA = isA ? cat : catb; gB = (bf16_t*)(wreg + W_MIX_OUT); gK = isA ? D : 512; e_mode = 1; e_perm = 0; e_scale = 1.0f; e_ob = xb; e_ssq_out = ssq + 0; }
                    else if (p == 9) { gB = (bf16_t*)(wreg + W_FIN_POST); gN = 2 * FF; e_mode = 0; e_ssq_in = ssq + 0; e_ob = hbuf; e_ldo = FF; }
                    else if (p == 10) { gA = hbuf; gB = (bf16_t*)(wreg + W_FOUT_POST); gK = FF; e_mode = 1; e_perm = 0; e_scale = 0.5f; e_ob = xb; e_ssq_out = ssq + 0; }
                    else { gB = (bf16_t*)(wreg + W_MIX_IN); gN = KVW; e_ssq_in = ssq + 0; e_ob = kvb; e_ldo = KVW; }
                    const pg8::Gemm g{gA, gB, gM, gN, gK};
                    const pg8::Epi E{e_mode, e_perm, (const gfloat*)e_ssq_in, (gbf16*)e_ob, e_ldo, (gfloat*)X, (const gfloat*)e_w0, (const gfloat*)e_a0};
                    if (p == 9 && l == 1) { __threadfence(); }
                    pg8::StaticOrder S; if (rep == 1) S.init(g.M, g.N, G / 2, bx - G / 2); else S.init(g.M, g.N, G, bx);
                    __syncthreads();
                    int tg = tid; asm volatile("" : "+v"(tg));
                    const float e_scale_s = __int_as_float(__builtin_amdgcn_readfirstlane(__float_as_int(e_scale)));
                    pg8::gemm_phase(lds, g, S, E, e_scale_s, (gfloat*)e_ssq_out, tg);
                    __syncthreads();
                }
            }
        } else if (p == 4) {
            if (isA) {
                const float* mu = PP->in[14] + (size_t)li * 2560 + 2304;
                const int j = ((int)gtid & 63) * 4;
                const f32x4 m4 = *(const f32x4*)(mu + j);
                for (long i0 = gtid; i0 < (long)T * 64; i0 += 4 * NGT) {
                    u32x2 a[4], b[4];
#pragma unroll
                    for (int u = 0; u < 4; ++u) { const long t = (i0 + u * NGT) >> 6;
                        a[u] = *(const u32x2*)(proj + t * AIN + 2304 + j);
                        const bool hp = (t & (SEQ - 1)) != 0; const unsigned mk = hp ? 0xffffffffu : 0u; b[u] = *(const u32x2*)(proj + (t - (hp ? 1 : 0)) * AIN + 2304 + j) & mk; }
#pragma unroll
                    for (int u = 0; u < 4; ++u) { const long t = (i0 + u * NGT) >> 6;
                        float v[4]; v[0] = bflo(a[u].x) + m4[0] * (bflo(b[u].x) - bflo(a[u].x)); v[1] = bfhi(a[u].x) + m4[1] * (bfhi(b[u].x) - bfhi(a[u].x));
                        v[2] = bflo(a[u].y) + m4[2] * (bflo(b[u].y) - bflo(a[u].y)); v[3] = bfhi(a[u].y) + m4[3] * (bfhi(b[u].y) - bfhi(a[u].y));
                        if (j < 64) {
#pragma unroll
                            for (int e = 0; e < 4; ++e) v[e] = 1.0f - 2.0f * __builtin_amdgcn_rcpf(1.0f + __expf(2.0f * v[e]));
                        } else if (j >= 128) {
#pragma unroll
                            for (int e = 0; e < 4; ++e) v[e] = sigmoidf_(v[e]);
                        }
                        u32x2 o; o.x = cvt_pk_bf16(v[0], v[1]); o.y = cvt_pk_bf16(v[2], v[3]);
                        *(u32x2*)(aprep + t * 256 + j) = o; }
                }
            }
            if (!isA) {
                AttnIn r;
                { const bf16_t* Qp; const bf16_t* Kp; const bf16_t* Vp; long qs, kvs; bool ck;
                  attn_decode_B(bx, l, qall, kvb, memkv, Qp, qs, Kp, Vp, kvs, ck); attn_issue(r, Qp, qs, Kp, Vp, kvs, ck, tid); }
                for (int u = bx; u < 4096; u += G) {
                    int tidu = tid; asm volatile("" : "+v"(tidu));
                    const int un = u + G; const bool hn = un < 4096;
                    const bf16_t* nQ = qall; const bf16_t* nK = kvb; const bf16_t* nV = kvb; long nqs = 0, nkvs = 0; bool nck = false;
                    if (hn) attn_decode_B(un, l, qall, kvb, memkv, nQ, nqs, nK, nV, nkvs, nck);
                    if (u < 3072) {
                        const int blk = u & 31, hh = (u >> 5) & 3, bg = u >> 7, g = bg % 3, b = bg / 3;
                        const int dil = (g == 0) ? 1 : ((g == 1) ? 4 : 16), nper = 32 / dil, c = blk / nper, n = blk % nper, head = g * 4 + hh;
                        const long tq0 = (long)b * SEQ + (long)(n * 128) * dil + c;
                        attn_run<1>(lds, r, n > 0 ? 1 : 0, PP->in[27] + li * 64, PP->in[31], PP->in[32], dil, head, og + tq0 * RW + head * 64, (long)dil * RW, lse + tq0 * 12 + head, (long)dil * 12, tidu,
                                    hn, nQ, nqs, nK, nV, nkvs, nck);
                    } else {
                        const int um = u - 3072, head = um & 3, tb = um >> 2; const long t0 = (long)tb * 128;
                        attn_run<0>(lds, r, 1, PP->in[11] + l * 64, PP->in[12] + l * 64, nullptr, 1, 0, catb + t0 * 512 + 256 + head * 64, 512, nullptr, 0, tidu,
                                    hn, nQ, nqs, nK, nV, nkvs, nck);
                    }
                }
            }
        } else if (p == 6) {
            if (bx >= 192) {
                const int sub = bx - 192, nsub = G - 192;
                for (int um = sub; um < 1024; um += nsub) {
                    int tidu = tid; asm volatile("" : "+v"(tidu));
                    const int head = um & 3, tb = um >> 2; const long t0 = (long)tb * 128; const int b = (int)(t0 / SEQ);
                    attn_unit<0>(lds, proj + t0 * AIN + 2560 + head * 64, AIN, memkv + (size_t)(b * 256) * 2048 + l * 512 + head * 64, memkv + (size_t)(b * 256) * 2048 + l * 512 + 256 + head * 64, 2048,
                                 1, PP->in[11] + l * 64, PP->in[12] + l * 64, nullptr, 1, 0, cat + t0 * D + RW + head * 64, D, nullptr, 0, tidu);
                }
                __syncthreads();
                const int gw2 = sub * 8 + wave, NGW2 = nsub * 8; const long gtid2 = (long)sub * 512 + tid, NGT2 = (long)nsub * 512;
                conv_group(PP, wreg, l, 2, scr, gw2, NGW2, gtid2, NGT2, lane);
                conv_group(PP, wreg, l + 1, (l == 0) ? (1 | 4 | 16) : 1, scr, gw2, NGW2, gtid2, NGT2, lane);
            }
            for (int task = bx; task < 192; task += G) {
                const int half = (task >> 3) & 1, bh = (task & 7) + 8 * (task >> 4);
                const int b = bh / 12, h = bh % 12;
                scan_task(lds, b, h, half, proj, lora, yscan, PP->in[14] + (size_t)li * 2560, PP->in[20] + li * RW, PP->in[21] + li * RW, tid);
            }
        } else if (p == 7) {
            const float* mu = PP->in[14] + (size_t)li * 2560; const float* k_a = PP->in[21] + li * RW; const float* r_k = PP->in[22] + li * RW;
            const float* lng = PP->in[23] + li * RW; const float* lnb = PP->in[24] + li * RW;
            const int q3 = gw % 3, tstep = NGW / 3; const int col = q3 * 256 + lane * 4;
            const f32x4 mr = *(const f32x4*)(mu + col), mk = *(const f32x4*)(mu + RW + col), mv = *(const f32x4*)(mu + 2 * RW + col);
            const f32x4 ka = *(const f32x4*)(k_a + col), rk4 = *(const f32x4*)(r_k + col), g4 = *(const f32x4*)(lng + col), b4 = *(const f32x4*)(lnb + col);
#define POST_LOAD(T_, S) \
                const bool hp##S = ((T_) & (SEQ - 1)) != 0; \
                const u32x2 yv##S = *(const u32x2*)(yscan + (T_) * RW + col); \
                const bf16_t* pp##S = proj + (T_) * AIN + col; \
                const u32x2 rt##S = *(const u32x2*)pp##S, kt##S = *(const u32x2*)(pp##S + RW), vt##S = *(const u32x2*)(pp##S + 2 * RW); \
                const bf16_t* pq##S = pp##S - (hp##S ? AIN : 0); const unsigned msk##S = hp##S ? 0xffffffffu : 0u; \
                const u32x2 rp##S = *(const u32x2*)pq##S & msk##S, kp##S = *(const u32x2*)(pq##S + RW) & msk##S, vp##S = *(const u32x2*)(pq##S + 2 * RW) & msk##S; \
                const u32x2 av##S = *(const u32x2*)(lora + (T_) * LORA_N + RW + col), gv##S = *(const u32x2*)(lora + (T_) * LORA_N + 2 * RW + col);
#define POST_COMP(T_, S) { \
                float y[4] = {bflo(yv##S.x), bfhi(yv##S.x), bflo(yv##S.y), bfhi(yv##S.y)}; \
                const float r0[4] = {bflo(rt##S.x), bfhi(rt##S.x), bflo(rt##S.y), bfhi(rt##S.y)}, r1[4] = {bflo(rp##S.x), bfhi(rp##S.x), bflo(rp##S.y), bfhi(rp##S.y)}; \
                const float k0[4] = {bflo(kt##S.x), bfhi(kt##S.x), bflo(kt##S.y), bfhi(kt##S.y)}, k1[4] = {bflo(kp##S.x), bfhi(kp##S.x), bflo(kp##S.y), bfhi(kp##S.y)}; \
                const float v0[4] = {bflo(vt##S.x), bfhi(vt##S.x), bflo(vt##S.y), bfhi(vt##S.y)}, v1[4] = {bflo(vp##S.x), bfhi(vp##S.x), bflo(vp##S.y), bfhi(vp##S.y)}; \
                const float aa[4] = {bflo(av##S.x), bfhi(av##S.x), bflo(av##S.y), bfhi(av##S.y)}, gg[4] = {bflo(gv##S.x), bfhi(gv##S.x), bflo(gv##S.y), bfhi(gv##S.y)}; \
                float mean = allsum16((y[0] + y[1]) + (y[2] + y[3])) * (1.0f / 64.0f); \
                float var = 0.f, sb = 0.f, vs[4]; \
                _Pragma("unroll") for (int e = 0; e < 4; ++e) { y[e] -= mean; var += y[e] * y[e]; \
                    const float rs = r0[e] + mr[e] * (r1[e] - r0[e]), ks = k0[e] + mk[e] * (k1[e] - k0[e]); vs[e] = v0[e] + mv[e] * (v1[e] - v0[e]); \
                    sb += rs * ks * (1.0f + (aa[e] - 1.0f) * ka[e]) * rk4[e]; } \
                var = allsum16(var) * (1.0f / 64.0f); sb = allsum16(sb); \
                const float rstd = rsqrtf(var + 64e-5f); \
                float o[4]; \
                _Pragma("unroll") for (int e = 0; e < 4; ++e) o[e] = (y[e] * rstd * g4[e] + b4[e] + sb * vs[e]) * gg[e]; \
                u32x2 ow; ow.x = cvt_pk_bf16(o[0], o[1]); ow.y = cvt_pk_bf16(o[2], o[3]); \
                *(u32x2*)(cat + (T_) * D + col) = ow; }
            for (long t = (gw < 3 * tstep) ? gw / 3 : T; t < T; t += 2 * tstep) {
                const long tB = t + tstep; const bool hasB = tB < T; const long tBc = hasB ? tB : t;
                POST_LOAD(t, A)
                POST_LOAD(tBc, B)
                POST_COMP(t, A)
                if (hasB) POST_COMP(tB, B)
            }
#undef POST_LOAD
#undef POST_COMP
        }
#if MK_SINGLE
        if (it + 2 < P.ph_hi * 2) { if (it == 0) cg::this_grid().sync(); else { XcdBarrier xb_; xb_.bar = (unsigned*)(ws + WS_BAR); xb_.x = xb_xcc_id(); xb_.st = (volatile LAS unsigned*)(lds + MISC_OFF); xcd_barrier(xb_, tid); } }
#endif
    }
}

#undef lane
#undef wave
#undef gw
#undef NGW
#undef gtid
#undef NGT
#undef scr
extern "C" void kernel_launch(void* const* d_in, const int* in_sizes, int n_in, void* d_out, int out_size, void* d_ws, size_t ws_size, hipStream_t stream) {
    static int ready = 0;
    if (!ready) {
        if (n_in != 33 || out_size != T * D || ws_size < WS_END) { fprintf(stderr, "kernel_launch: unexpected shapes (n_in %d out %d ws %zu)\n", n_in, out_size, ws_size); ready = -1; return; }
        if (hipFuncSetAttribute((const void*)fwd_kernel, hipFuncAttributeMaxDynamicSharedMemorySize, LDS_BYTES) != hipSuccess) { fprintf(stderr, "kernel_launch: hipFuncSetAttribute failed\n"); ready = -1; return; }
        int per_cu = 0;
        hipOccupancyMaxActiveBlocksPerMultiprocessor(&per_cu, (const void*)fwd_kernel, 512, LDS_BYTES);
        if (per_cu < 1) fprintf(stderr, "kernel_launch: occupancy query says %d blocks per CU\n", per_cu);
        (void)hipGetLastError();
        ready = 1;
    }
    if (ready < 0) return;
    Params p{};
    for (int i = 0; i < 33; ++i) p.in[i] = (const float*)d_in[i];
    p.out = (float*)d_out; p.ws = (unsigned char*)d_ws;
    const int grid = 256;
#if MK_SINGLE
    hipMemsetAsync((char*)d_ws + WS_BAR, 0, 16384, stream);
    p.ph_lo = 0; p.ph_hi = 48;
    void* args[] = {&p};
    hipError_t e = hipLaunchCooperativeKernel((const void*)fwd_kernel, dim3(grid), dim3(512), args, LDS_BYTES, stream);
    if (e != hipSuccess) fprintf(stderr, "cooperative launch failed: %s\n", hipGetErrorString(e));
#else
    for (int ph = 0; ph < 48; ++ph) {
        const int l = ph / 12, q = ph % 12; const bool isA = l < 2;
        if ((!isA && (q == 6 || q == 7)) || (q == 11 && l != 1) || (q == 0 && l != 0)) continue;
        p.ph_lo = ph; p.ph_hi = ph + 1;
        hipLaunchKernelGGL(fwd_kernel, dim3(grid), dim3(512), LDS_BYTES, stream, p);
    }
#endif
}
```

```cpp
#include <hip/hip_runtime.h>
#include <hip/hip_cooperative_groups.h>
#include <cstdio>
namespace cg = cooperative_groups;

#ifndef MK_SINGLE
#define MK_SINGLE 1
#endif

#define LAS __attribute__((address_space(3)))
typedef unsigned short bf16_t;
typedef short bf16x8 __attribute__((ext_vector_type(8)));
typedef short bf16x4 __attribute__((ext_vector_type(4)));
typedef float f32x4 __attribute__((ext_vector_type(4)));
typedef float f32x2 __attribute__((ext_vector_type(2)));
typedef unsigned u32x4 __attribute__((ext_vector_type(4)));
typedef unsigned u32x2 __attribute__((ext_vector_type(2)));
#define GAS __attribute__((address_space(1)))
typedef GAS float gfloat;
typedef GAS unsigned short gbf16;

constexpr int T = 32768, D = 1024, FF = 2816, SEQ = 4096;
constexpr int AIN = 2816, RW = 768, LORA_N = 2304, KVW = 1536;
constexpr float NORM_EPS = 1e-6f;
constexpr size_t MiB = 1u << 20;
constexpr size_t WS_SSQ = 0;
constexpr size_t WS_MEMSSQ = 3584 * 1024;
constexpr size_t WS_LSE = 2 * MiB;
constexpr size_t WS_BAR = 3840 * 1024;
constexpr size_t WS_MEMB = 4 * MiB;
constexpr size_t WS_MEMKV = 8 * MiB;
constexpr size_t WS_W = 16 * MiB;
constexpr size_t WS_XB = 60 * MiB;
constexpr size_t WS_H = 124 * MiB;
constexpr size_t WS_LORA = 300 * MiB;
constexpr size_t WS_CAT = 444 * MiB;
constexpr size_t WS_END = 508 * MiB;
constexpr size_t W_FIN_PRE = 0, W_FOUT_PRE = 11 * MiB, W_FIN_POST = 16 * MiB + 512 * 1024, W_FOUT_POST = 27 * MiB + 512 * 1024,
                 W_MIX_IN = 33 * MiB, W_MIX_OUT = 38 * MiB + 512 * 1024, W_LORA = 40 * MiB + 512 * 1024;
constexpr int LDS_BYTES = 147456, MISC_OFF = 147456 - 64;
#ifndef EXP_DELAY
#define EXP_DELAY 0
#endif
#ifndef DUPMASK
#define DUPMASK 0
#endif

__device__ __forceinline__ unsigned cvt_pk_bf16(float lo, float hi) { unsigned r; asm volatile("v_cvt_pk_bf16_f32 %0, %1, %2" : "=v"(r) : "v"(lo), "v"(hi)); return r; }
__device__ __forceinline__ float bflo(unsigned u) { return __uint_as_float(u << 16); }
__device__ __forceinline__ float bfhi(unsigned u) { return __uint_as_float(u & 0xffff0000u); }
__device__ __forceinline__ float bf1(bf16_t v) { return __uint_as_float((unsigned)v << 16); }
__device__ __forceinline__ float sigmoidf_(float x) { return __builtin_amdgcn_rcpf(1.0f + __expf(-x)); }
__device__ __forceinline__ float xsum_rows(float s) {
    const auto r = __builtin_amdgcn_permlane16_swap(__float_as_uint(s), __float_as_uint(s), false, false);
    s = __uint_as_float(r[0]) + __uint_as_float(r[1]);
    const auto q = __builtin_amdgcn_permlane32_swap(__float_as_uint(s), __float_as_uint(s), false, false);
    return __uint_as_float(q[0]) + __uint_as_float(q[1]);
}
template <int CTRL> __device__ __forceinline__ float dpp_f(float v) { return __int_as_float(__builtin_amdgcn_update_dpp(0, __float_as_int(v), CTRL, 0xf, 0xf, false)); }
__device__ __forceinline__ float allsum16(float v) {
    v += dpp_f<0x128>(v);
    v += dpp_f<0x124>(v);
    v += dpp_f<0x122>(v);
    v += dpp_f<0x121>(v);
    return v;
}

namespace pg8 {
constexpr int BM = 256, BK = 64, HALF = 128, HTB = HALF * BK * 2, STAGE_BYTES = 8 * HTB, NXCD = 8, WGM = 8;
__device__ __forceinline__ int lds_byte(int r, int c) { const int st = (r >> 4) * 2 + (c >> 5), rr = r & 15, cc = c & 31, ob = rr * 64 + cc * 2; return st * 1024 + (ob ^ (((ob >> 9) & 1) << 5)); }
__device__ __forceinline__ void stage_rc(int b, int& R, int& C) { const int st = b / 1024, sb = b % 1024, swz = sb ^ (((sb >> 9) & 1) << 5); R = (st >> 1) * 16 + swz / 64; C = (st & 1) * 32 + (swz % 64) / 2; }
__device__ __forceinline__ int perm32(int rho) { const int n = rho >> 4, i = rho & 15; return 8 * (i >> 2) + 4 * n + (i & 3); }
struct Unit { int pm, pn; };
struct Gemm { const bf16_t* A; const bf16_t* Bt; int M, N, K; };
struct StaticOrder {
    int nM, nN, nwg, G, c;
    __device__ void init(int M, int N, int G_, int c_) { nM = M / BM; nN = N / BM; nwg = nM * nN; G = G_; c = c_; }
    __device__ bool next(int i, Unit& u) const {
        const long L = (long)i * G + c; if (L >= nwg) return false;
        int wgid = (int)L; { const int q = nwg / NXCD, r = nwg % NXCD, xcd = wgid % NXCD, off = wgid / NXCD; wgid = (xcd < r ? xcd * (q + 1) : r * (q + 1) + (xcd - r) * q) + off; }
        const int nig = WGM * nN, gid = wgid / nig, fm = gid * WGM, gsz = (nM - fm) < WGM ? (nM - fm) : WGM;
        u.pm = fm + ((wgid % nig) % gsz); u.pn = (wgid % nig) / gsz; return true;
    }
};

struct Epi {
    int mode, perm;
    const gfloat* ssq_in; gbf16* ob; int ldo;
    gfloat* x;
    const gfloat* w0; const gfloat* a0;
    template <int NR> __device__ __forceinline__ void rstdN(float (&rs)[NR], int rowbase, int fq) const {
        const GAS f32x4* bp = (const GAS f32x4*)(ssq_in + (size_t)rowbase * 16 + 4 * fq);
        f32x4 p[NR];
#pragma unroll
        for (int m = 0; m < NR; ++m) p[m] = bp[m * 64];
        asm volatile("" :: "v"(bp));
#pragma unroll
        for (int m = 0; m < NR; ++m) {
            float s = (p[m][0] + p[m][1]) + (p[m][2] + p[m][3]);
            s = xsum_rows(s);
            rs[m] = rsqrtf(s * (1.0f / 1024.0f) + NORM_EPS);
        }
    }
    __device__ __forceinline__ void rstd8(float (&rs)[2][4], int row0, int fq) const {
        const GAS f32x4* b0 = (const GAS f32x4*)(ssq_in + (size_t)row0 * 16 + 4 * fq);
        const GAS f32x4* b1 = (const GAS f32x4*)(ssq_in + (size_t)(row0 + HALF) * 16 + 4 * fq);
        f32x4 p[2][4];
#pragma unroll
        for (int m = 0; m < 4; ++m) { p[0][m] = b0[m * 64]; p[1][m] = b1[m * 64]; }
        asm volatile("" :: "v"(b0), "v"(b1));
#pragma unroll
        for (int ai = 0; ai < 2; ++ai)
#pragma unroll
            for (int m = 0; m < 4; ++m) {
                float s = (p[ai][m][0] + p[ai][m][1]) + (p[ai][m][2] + p[ai][m][3]);
                s = xsum_rows(s);
                rs[ai][m] = rsqrtf(s * (1.0f / 1024.0f) + NORM_EPS);
            }
    }
    __device__ __forceinline__ float row_rstd(int row, int fq) const {
        const f32x4 p = *(const GAS f32x4*)(ssq_in + (size_t)row * 16 + 4 * fq);
        float s = (p[0] + p[1]) + (p[2] + p[3]);
        s += __shfl_xor(s, 16); s += __shfl_xor(s, 32);
        return rsqrtf(s * (1.0f / 1024.0f) + NORM_EPS);
    }
    template <int KIND> __device__ __forceinline__ void epi_bf16(const f32x4 (&acc)[2][2][4][2], const Unit& u, int row0, int wc, int fq) const {
        const int colt = u.pn * BM + wc * 32 + 8 * fq;
        const int seg = (KIND == 1) ? 0 : ((KIND == 2) ? 1 : 2);
        f32x4 bv[2][2];
        if (KIND == 1 || KIND == 2) {
            const GAS f32x4* bp = (const GAS f32x4*)((KIND == 1 ? w0 : a0) + (colt - seg * RW));
            bv[0][0] = bp[0]; bv[0][1] = bp[1]; bv[1][0] = bp[32]; bv[1][1] = bp[33];
            asm volatile("" :: "v"(bp));
        }
#pragma unroll
        for (int ai = 0; ai < 2; ++ai) {
            float rsv[4] = {1.0f, 1.0f, 1.0f, 1.0f};
            if (KIND == 0) rstdN<4>(rsv, row0 + ai * HALF, fq);
#pragma unroll
            for (int m = 0; m < 4; ++m) {
                const int row = row0 + ai * HALF + m * 16;
                const float rs = rsv[m];
#pragma unroll
                for (int bj = 0; bj < 2; ++bj) {
                    const int col = colt + bj * HALF;
                    float v[8];
#pragma unroll
                    for (int n = 0; n < 2; ++n)
#pragma unroll
                        for (int j = 0; j < 4; ++j) v[n * 4 + j] = acc[ai][bj][m][n][j] * rs;
                    if (KIND == 1) {
#pragma unroll
                        for (int e = 0; e < 8; ++e) v[e] = -0.60653066f * sigmoidf_(bv[bj][e >> 2][e & 3] + v[e]);
                    } else if (KIND == 2) {
#pragma unroll
                        for (int e = 0; e < 8; ++e) v[e] = sigmoidf_(bv[bj][e >> 2][e & 3] + v[e]);
                    }
                    u32x4 w; w.x = cvt_pk_bf16(v[0], v[1]); w.y = cvt_pk_bf16(v[2], v[3]); w.z = cvt_pk_bf16(v[4], v[5]); w.w = cvt_pk_bf16(v[6], v[7]);
                    *(GAS u32x4*)(ob + (size_t)row * ldo + col) = w;
                }
            }
        }
    }
    template <int AI, int M0> __device__ __forceinline__ void epi1_pair(const f32x4 (&acc)[2][2][4][2], int row0, int col0, int fq, const float scale, gfloat* ssq_out, int slot) const {
        const int rowa = row0 + AI * HALF + M0 * 16, rowb = rowa + 16;
        GAS f32x4* xa = (GAS f32x4*)(x + (size_t)rowa * D + col0); GAS f32x4* xb_ = (GAS f32x4*)(x + (size_t)rowb * D + col0);
        f32x4 va[2][2], vb[2][2];
#pragma unroll
        for (int bj = 0; bj < 2; ++bj)
#pragma unroll
            for (int n = 0; n < 2; ++n) { va[bj][n] = xa[bj * 32 + n * 4]; vb[bj][n] = xb_[bj * 32 + n * 4]; }
        asm volatile("" :: "v"(xa), "v"(xb_));
        GAS u32x2* oa = (GAS u32x2*)(ob + (size_t)rowa * D + col0); GAS u32x2* ob2 = (GAS u32x2*)(ob + (size_t)rowb * D + col0);
        float ssa = 0.f, ssb = 0.f;
#pragma unroll
        for (int bj = 0; bj < 2; ++bj)
#pragma unroll
            for (int n = 0; n < 2; ++n) {
                const f32x4 a = va[bj][n] + acc[AI][bj][M0][n] * scale, b = vb[bj][n] + acc[AI][bj][M0 + 1][n] * scale;
                xa[bj * 32 + n * 4] = a; xb_[bj * 32 + n * 4] = b;
                u32x2 wa; wa.x = cvt_pk_bf16(a[0], a[1]); wa.y = cvt_pk_bf16(a[2], a[3]); oa[bj * 32 + n * 4] = wa;
                u32x2 wb; wb.x = cvt_pk_bf16(b[0], b[1]); wb.y = cvt_pk_bf16(b[2], b[3]); ob2[bj * 32 + n * 4] = wb;
                ssa += (a[0] * a[0] + a[1] * a[1]) + (a[2] * a[2] + a[3] * a[3]);
                ssb += (b[0] * b[0] + b[1] * b[1]) + (b[2] * b[2] + b[3] * b[3]);
            }
        ssa = xsum_rows(ssa); ssb = xsum_rows(ssb);
        if (fq == 0) { ssq_out[(size_t)rowa * 16 + slot] = ssa; ssq_out[(size_t)rowb * 16 + slot] = ssb; }
    }
    __device__ __forceinline__ void operator()(const f32x4 (&acc)[2][2][4][2], const Unit& u, int wr, int wc, int fr, int fq, const float scale, gfloat* ssq_out) const {
        const int row0 = u.pm * BM + wr * 64 + fr;
        if (mode == 0) {
            const int col0 = u.pn * 128 + wc * 32 + 8 * fq;
#pragma unroll
            for (int ai = 0; ai < 2; ++ai) {
                float rsv[4];
                rstdN<4>(rsv, row0 + ai * HALF, fq);
#pragma unroll
                for (int m = 0; m < 4; ++m) {
                    const int row = row0 + ai * HALF + m * 16;
                    const float rs = rsv[m];
                    float hv[8];
                    const float rsl = rs * -1.44269504f, irs2 = __builtin_amdgcn_rcpf(rs * rs);
#pragma unroll
                    for (int n = 0; n < 2; ++n)
#pragma unroll
                        for (int j = 0; j < 4; ++j) { const float ag = acc[ai][0][m][n][j], au = acc[ai][1][m][n][j];
                            hv[n * 4 + j] = (ag * au) * __builtin_amdgcn_rcpf(__builtin_fmaf(__builtin_amdgcn_exp2f(ag * rsl), irs2, irs2)); }
                    u32x4 w; w.x = cvt_pk_bf16(hv[0], hv[1]); w.y = cvt_pk_bf16(hv[2], hv[3]); w.z = cvt_pk_bf16(hv[4], hv[5]); w.w = cvt_pk_bf16(hv[6], hv[7]);
                    *(GAS u32x4*)(ob + (size_t)row * ldo + col0) = w;
                }
            }
        } else if (mode == 1) {
            const int col0 = u.pn * BM + wc * 32 + 4 * fq;
            epi1_pair<0, 0>(acc, row0, col0, fq, scale, ssq_out, u.pn * 4 + wc); epi1_pair<0, 2>(acc, row0, col0, fq, scale, ssq_out, u.pn * 4 + wc);
            epi1_pair<1, 0>(acc, row0, col0, fq, scale, ssq_out, u.pn * 4 + wc); epi1_pair<1, 2>(acc, row0, col0, fq, scale, ssq_out, u.pn * 4 + wc);
        } else {
            if (mode == 2) epi_bf16<0>(acc, u, row0, wc, fq);
            else { const int seg = u.pn / 3; if (seg == 0) epi_bf16<1>(acc, u, row0, wc, fq); else if (seg == 1) epi_bf16<2>(acc, u, row0, wc, fq); else epi_bf16<3>(acc, u, row0, wc, fq); }
        }
    }
};

__device__ __forceinline__ void gemm_phase(LAS unsigned char* lds, const Gemm g, const StaticOrder& S, const Epi E, const float e_scale, gfloat* e_ssq_out, const int tid) {
    const int wid = __builtin_amdgcn_readfirstlane(tid >> 6), lane = tid & 63, wr = wid >> 2, wc = wid & 3, fr = lane & 15, fq = lane >> 4;
    const int K = g.K, nt = K / BK;
    unsigned voffA[2], voffB[2];
#pragma unroll
    for (int i = 0; i < 2; ++i) { int R, C; stage_rc(tid * 16 + i * 8192, R, C); const int Rb = E.perm ? ((R & ~31) + perm32(R & 31)) : R;
        voffA[i] = (unsigned)(R * K + C) * 2u; voffB[i] = (unsigned)(Rb * K + C) * 2u; }
    const size_t kstep = (size_t)(BK * 2);
    const size_t hstep = (size_t)HALF * K * 2;
    const size_t tstep = 2 * hstep;
    const unsigned ldsw = (unsigned)wid * 1024u;
    const int aoff = lds_byte(wr * 64 + fr, fq * 8), boff = lds_byte(wc * 32 + fr, fq * 8);
#define PG8_SA(b, h) (((b) * 2 + (h)) * HTB)
#define PG8_SB(b, h) ((4 + (b) * 2 + (h)) * HTB)
#define PG8_STAGE(bufoff, gbase, voff) do { _Pragma("unroll") for (int _i = 0; _i < 2; ++_i) \
        __builtin_amdgcn_global_load_lds((const unsigned*)((const char*)(gbase) + (voff)[_i]), (LAS unsigned*)(lds + (bufoff) + ldsw + _i * 8192), 16, 0, 0); } while (0)
#define PG8_LDA(dst, b, h) do { _Pragma("unroll") for (int m = 0; m < 4; ++m) _Pragma("unroll") for (int k = 0; k < 2; ++k) dst[m][k] = *(const LAS bf16x8*)(lds + PG8_SA(b, h) + aoff + m * 2048 + k * 1024); } while (0)
#define PG8_LDB(dst, b, h) do { _Pragma("unroll") for (int n = 0; n < 2; ++n) _Pragma("unroll") for (int k = 0; k < 2; ++k) dst[n][k] = *(const LAS bf16x8*)(lds + PG8_SB(b, h) + boff + n * 2048 + k * 1024); } while (0)
#define PG8_MMA(ai, bj, At, Bt) do { __builtin_amdgcn_s_setprio(1); _Pragma("unroll") for (int m = 0; m < 4; ++m) _Pragma("unroll") for (int n = 0; n < 2; ++n) _Pragma("unroll") for (int k = 0; k < 2; ++k) \
        acc[ai][bj][m][n] = __builtin_amdgcn_mfma_f32_16x16x32_bf16(Bt[n][k], At[m][k], acc[ai][bj][m][n], 0, 0, 0); __builtin_amdgcn_s_setprio(0); } while (0)
#define PG8_WAIT_V(n) asm volatile("s_waitcnt vmcnt(" #n ")" ::: "memory")
#define PG8_WAIT_L(n) asm volatile("s_waitcnt lgkmcnt(" #n ")" ::: "memory")
#define PG8_BAR __builtin_amdgcn_s_barrier()
#define PG8_SCHED __builtin_amdgcn_sched_barrier(0)
    Unit cur, nxt; int ui = 0;
    if (!S.next(0, cur)) return;
    f32x4 acc[2][2][4][2];
#pragma unroll
    for (int a = 0; a < 2; ++a)
#pragma unroll
        for (int b = 0; b < 2; ++b)
#pragma unroll
            for (int m = 0; m < 4; ++m)
#pragma unroll
                for (int n = 0; n < 2; ++n) acc[a][b][m][n] = (f32x4){0.f, 0.f, 0.f, 0.f};
    bf16x8 At[4][2], B0[2][2], B1[2][2];
    const char* cA = (const char*)g.A + (size_t)cur.pm * tstep; const char* cB = (const char*)g.Bt + (size_t)cur.pn * tstep;
    PG8_STAGE(PG8_SB(0, 0), cB, voffB); PG8_STAGE(PG8_SA(0, 0), cA, voffA); PG8_STAGE(PG8_SB(0, 1), cB + hstep, voffB); PG8_STAGE(PG8_SA(0, 1), cA + hstep, voffA);
    if (wr == 1) PG8_BAR;
    PG8_WAIT_V(4); PG8_BAR;
    PG8_STAGE(PG8_SB(1, 0), cB + kstep, voffB); PG8_STAGE(PG8_SA(1, 0), cA + kstep, voffA); PG8_STAGE(PG8_SB(1, 1), cB + hstep + kstep, voffB);
    PG8_WAIT_V(6); PG8_BAR;
    for (;;) {
        const bool has_next = S.next(ui + 1, nxt);
        const char* nA = has_next ? (const char*)g.A + (size_t)nxt.pm * tstep : cA; const char* nB = has_next ? (const char*)g.Bt + (size_t)nxt.pn * tstep : cB;
        for (int t = 0; t < nt; t += 2) {
            const bool last = (t == nt - 2);
            const char* a1 = cA + (size_t)(t + 1) * kstep;
            const char* a2 = last ? nA : cA + (size_t)(t + 2) * kstep; const char* b2 = last ? nB : cB + (size_t)(t + 2) * kstep;
            const char* a3 = a2 + kstep; const char* b3 = b2 + kstep;
            PG8_LDB(B0, 0, 0); PG8_SCHED; PG8_LDA(At, 0, 0); PG8_STAGE(PG8_SA(1, 1), a1 + hstep, voffA);
            PG8_WAIT_L(8); PG8_BAR; PG8_WAIT_L(0); PG8_MMA(0, 0, At, B0); PG8_BAR; PG8_SCHED;
            PG8_LDB(B1, 0, 1); PG8_STAGE(PG8_SB(0, 0), b2, voffB);
            PG8_BAR; PG8_WAIT_L(0); PG8_MMA(0, 1, At, B1); PG8_BAR;
            PG8_LDA(At, 0, 1); PG8_STAGE(PG8_SA(0, 0), a2, voffA);
            PG8_BAR; PG8_WAIT_L(0); PG8_MMA(1, 0, At, B0); PG8_BAR; PG8_SCHED;
            PG8_STAGE(PG8_SB(0, 1), b2 + hstep, voffB);
            PG8_WAIT_V(6); PG8_BAR; PG8_MMA(1, 1, At, B1); PG8_BAR;
            PG8_LDB(B0, 1, 0); PG8_SCHED; PG8_LDA(At, 1, 0); PG8_STAGE(PG8_SA(0, 1), a2 + hstep, voffA);
            PG8_WAIT_L(8); PG8_BAR; PG8_WAIT_L(0); PG8_MMA(0, 0, At, B0); PG8_BAR; PG8_SCHED;
            PG8_LDB(B1, 1, 1); PG8_STAGE(PG8_SB(1, 0), b3, voffB);
            PG8_BAR; PG8_WAIT_L(0); PG8_MMA(0, 1, At, B1); PG8_BAR;
            PG8_LDA(At, 1, 1); PG8_STAGE(PG8_SA(1, 0), a3, voffA);
            PG8_BAR; PG8_WAIT_L(0); PG8_MMA(1, 0, At, B0); PG8_BAR; PG8_SCHED;
            PG8_STAGE(PG8_SB(1, 1), b3 + hstep, voffB);
            PG8_WAIT_V(6); PG8_BAR; PG8_MMA(1, 1, At, B1); PG8_BAR;
        }
        E(acc, cur, wr, wc, fr, fq, e_scale, e_ssq_out);
#if EXP_DELAY
        if (E.mode == 0) { __builtin_amdgcn_s_sleep(100); __builtin_amdgcn_s_sleep(100); }
#endif
        if (!has_next) break;
#pragma unroll
        for (int a = 0; a < 2; ++a)
#pragma unroll
            for (int b = 0; b < 2; ++b)
#pragma unroll
                for (int m = 0; m < 4; ++m)
#pragma unroll
                    for (int n = 0; n < 2; ++n) acc[a][b][m][n] = (f32x4){0.f, 0.f, 0.f, 0.f};
        cur = nxt; cA = nA; cB = nB; ++ui;
    }
    PG8_WAIT_V(0);
    if (wr == 0) PG8_BAR;
    PG8_BAR;
#undef PG8_SA
#undef PG8_SB
#undef PG8_STAGE
#undef PG8_LDA
#undef PG8_LDB
#undef PG8_MMA
#undef PG8_WAIT_V
#undef PG8_WAIT_L
#undef PG8_BAR
#undef PG8_SCHED
}
}

struct Params { const float* in[33]; float* out; unsigned char* ws; int ph_lo, ph_hi; };

__device__ __forceinline__ void conv_T(const float* W, int K, int N, bf16_t* WT, const float* gain, int swi, int row_off, LAS float* scr, int gw, int NGW, int lane) {
    const int nblk = N / 32, nitems = (K / 64) * nblk;
    f32x4 tv[8];
    if (gw < nitems) {
        const int kb = gw / nblk, nb = gw % nblk;
        const float* wp = W + (size_t)(64 * kb + (lane >> 3)) * N + 32 * nb + 4 * (lane & 7);
#pragma unroll
        for (int i = 0; i < 8; ++i) tv[i] = *(const f32x4*)(wp + (size_t)(8 * i) * N);
    }
    for (int item = gw; item < nitems; item += NGW) {
        const int kb = item / nblk, nb = item % nblk, k0 = 64 * kb, n0 = 32 * nb;
#pragma unroll
        for (int i = 0; i < 8; ++i) { LAS float* d = scr + (8 * i + (lane >> 3)) * 33 + 4 * (lane & 7); d[0] = tv[i][0]; d[1] = tv[i][1]; d[2] = tv[i][2]; d[3] = tv[i][3]; }
        if (item + NGW < nitems) {
            const int it2 = item + NGW, kb2 = it2 / nblk, nb2 = it2 % nblk;
            const float* wp = W + (size_t)(64 * kb2 + (lane >> 3)) * N + 32 * nb2 + 4 * (lane & 7);
#pragma unroll
            for (int i = 0; i < 8; ++i) tv[i] = *(const f32x4*)(wp + (size_t)(8 * i) * N);
        }
        asm volatile("s_waitcnt lgkmcnt(0)" ::: "memory");
        int drow0;
        if (swi) { const int j0 = (n0 < FF) ? n0 : n0 - FF; drow0 = 256 * (j0 >> 7) + (j0 & 127) + ((n0 < FF) ? 0 : 128); } else drow0 = row_off + n0;
        const int c = lane & 7;
        float gv[8];
#pragma unroll
        for (int e = 0; e < 8; ++e) gv[e] = gain ? gain[k0 + 8 * c + e] : 1.0f;
#pragma unroll
        for (int j = 0; j < 4; ++j) { const int n = (lane >> 3) + 8 * j; const LAS float* s = scr + (8 * c) * 33 + n;
            u32x4 o; o.x = cvt_pk_bf16(s[0 * 33] * gv[0], s[1 * 33] * gv[1]); o.y = cvt_pk_bf16(s[2 * 33] * gv[2], s[3 * 33] * gv[3]);
            o.z = cvt_pk_bf16(s[4 * 33] * gv[4], s[5 * 33] * gv[5]); o.w = cvt_pk_bf16(s[6 * 33] * gv[6], s[7 * 33] * gv[7]);
            *(u32x4*)(WT + (size_t)(drow0 + n) * K + k0 + 8 * c) = o; }
        asm volatile("s_waitcnt lgkmcnt(0)" ::: "memory");
    }
}

constexpr int KS_PITCH = 72, VT_PITCH = 272;
constexpr int AT_KS = 0, AT_VT = 256 * KS_PITCH * 2, AT_RK = AT_VT + 64 * VT_PITCH * 2, AT_TB = AT_RK + 1024;
struct AttnIn { u32x4 k[4], v[4], q0, q1; };
__device__ __forceinline__ void attn_issue_kv(AttnIn& r, const bf16_t* Kp, const bf16_t* Vp, long kv_stride, bool clampk, const int tid) {
#pragma unroll
    for (int i = 0; i < 4; ++i) {
        { const int id = tid + 512 * i, key = id >> 3, ck = id & 7; const int krow = (clampk && key < 128) ? key + 128 : key;
          r.k[i] = *(const u32x4*)(Kp + (long)krow * kv_stride + ck * 8); }
        { const int id = tid + 512 * i, key = id & 255, ck = id >> 8; const int krow = (clampk && key < 128) ? key + 128 : key;
          r.v[i] = *(const u32x4*)(Vp + (long)krow * kv_stride + ck * 8); }
    }
}
__device__ __forceinline__ void attn_issue_q(AttnIn& r, const bf16_t* Qp, long q_stride, const int tid) {
    const int lane = tid & 63, w = tid >> 6, fr = lane & 15, fq = lane >> 4;
    const int qi = 16 * w + fr;
    r.q0 = *(const u32x4*)(Qp + (long)qi * q_stride + 8 * fq); r.q1 = *(const u32x4*)(Qp + (long)qi * q_stride + 32 + 8 * fq);
}
__device__ __forceinline__ void attn_issue(AttnIn& r, const bf16_t* Qp, long q_stride, const bf16_t* Kp, const bf16_t* Vp, long kv_stride, bool clampk, const int tid) {
    attn_issue_kv(r, Kp, Vp, kv_stride, clampk, tid); attn_issue_q(r, Qp, q_stride, tid);
}
template <int MODE> __device__ __forceinline__ void attn_run(LAS unsigned char* lds, AttnIn& r,
                                          int first, const float* qg1, const float* qg2, const float* rel_bias, int dil, int head,
                                          bf16_t* Op, long o_stride, float* lsep, long lse_stride, const int tid,
                                          bool has_next, const bf16_t* nQp, long nq_stride, const bf16_t* nKp, const bf16_t* nVp, long nkv_stride, bool nclamp) {
    const int lane = tid & 63, w = tid >> 6, fr = lane & 15, fq = lane >> 4;
    LAS bf16_t* Ks = (LAS bf16_t*)(lds + AT_KS); LAS bf16_t* Vt = (LAS bf16_t*)(lds + AT_VT);
    LAS float* rk = (LAS float*)(lds + AT_RK); LAS float* tb = (LAS float*)(lds + AT_TB);
    __syncthreads();
#pragma unroll
    for (int i = 0; i < 4; ++i) {
        { const int id = tid + 512 * i, key = id >> 3, ck = id & 7;
          const u32x4 kx = r.k[i];
          *(LAS u32x4*)(Ks + key * KS_PITCH + ck * 8) = kx;
          float ss = 0.f;
#pragma unroll
          for (int e = 0; e < 4; ++e) { const float a = bflo(kx[e]), b = bfhi(kx[e]); ss += a * a + b * b; }
          ss += __shfl_xor(ss, 1); ss += __shfl_xor(ss, 2); ss += __shfl_xor(ss, 4);
          if (ck == 0) rk[key] = rsqrtf(ss * (1.0f / 64.0f) + NORM_EPS); }
        { const int id = tid + 512 * i, key = id & 255, ck = id >> 8;
          const u32x4 vx = r.v[i];
#pragma unroll
          for (int e = 0; e < 4; ++e) { Vt[(ck * 8 + 2 * e) * VT_PITCH + key] = (bf16_t)(vx[e] & 0xffffu); Vt[(ck * 8 + 2 * e + 1) * VT_PITCH + key] = (bf16_t)(vx[e] >> 16); } }
    }
    if (MODE == 1 && tid < 129) {
        const int dist = tid * dil; int bucket;
        if (dist < 16) bucket = dist;
        else { const float v = logf((float)dist / 16.0f) / 4.852030263919617f * 16.0f; int lg = 16 + (int)v; bucket = lg < 31 ? lg : 31; }
        tb[tid] = rel_bias[bucket * 12 + head];
    }
    const int qi = 16 * w + fr;
    bf16x8 Qf0, Qf1; float rq;
    {
        const u32x4 q0 = r.q0, q1 = r.q1;
        float v0[8], v1[8]; float ss = 0.f;
#pragma unroll
        for (int e = 0; e < 4; ++e) { v0[2 * e] = bflo(q0[e]); v0[2 * e + 1] = bfhi(q0[e]); v1[2 * e] = bflo(q1[e]); v1[2 * e + 1] = bfhi(q1[e]); }
#pragma unroll
        for (int e = 0; e < 8; ++e) ss += v0[e] * v0[e] + v1[e] * v1[e];
        ss += __shfl_xor(ss, 16); ss += __shfl_xor(ss, 32);
        rq = rsqrtf(ss * (1.0f / 64.0f) + NORM_EPS) * 0.125f;
#pragma unroll
        for (int e = 0; e < 8; ++e) { v0[e] *= qg1[8 * fq + e] * qg2[8 * fq + e]; v1[e] *= qg1[32 + 8 * fq + e] * qg2[32 + 8 * fq + e]; }
        u32x4 a, b;
        a.x = cvt_pk_bf16(v0[0], v0[1]); a.y = cvt_pk_bf16(v0[2], v0[3]); a.z = cvt_pk_bf16(v0[4], v0[5]); a.w = cvt_pk_bf16(v0[6], v0[7]);
        b.x = cvt_pk_bf16(v1[0], v1[1]); b.y = cvt_pk_bf16(v1[2], v1[3]); b.z = cvt_pk_bf16(v1[4], v1[5]); b.w = cvt_pk_bf16(v1[6], v1[7]);
        Qf0 = __builtin_bit_cast(bf16x8, a); Qf1 = __builtin_bit_cast(bf16x8, b);
    }
    if (has_next) attn_issue_kv(r, nKp, nVp, nkv_stride, nclamp, tid);
    __syncthreads();
    constexpr int NB = (MODE == 1) ? 9 : 16, NS = (MODE == 1) ? 10 : 16;
    f32x4 s[NS];
#pragma unroll
    for (int i = 0; i < NB; ++i) {
        const int nb = (MODE == 1) ? (w + i) : i;
        const bf16x8 ka0 = *(const LAS bf16x8*)(Ks + (16 * nb + fr) * KS_PITCH + 8 * fq), ka1 = *(const LAS bf16x8*)(Ks + (16 * nb + fr) * KS_PITCH + 32 + 8 * fq);
        f32x4 z = (f32x4){0.f, 0.f, 0.f, 0.f};
        z = __builtin_amdgcn_mfma_f32_16x16x32_bf16(ka0, Qf0, z, 0, 0, 0);
        s[i] = __builtin_amdgcn_mfma_f32_16x16x32_bf16(ka1, Qf1, z, 0, 0, 0);
    }
    if (has_next) attn_issue_q(r, nQp, nq_stride, tid);
    if (MODE == 1) s[9] = (f32x4){0.f, 0.f, 0.f, 0.f};
    float mx = -3.0e38f;
#pragma unroll
    for (int i = 0; i < NB; ++i)
#pragma unroll
        for (int j = 0; j < 4; ++j) {
            const int key = 16 * ((MODE == 1) ? (w + i) : i) + 4 * fq + j;
            float lg = s[i][j] * rq * rk[key];
            if (MODE == 1) {
                const int dsub = 128 + qi - key;
                const bool valid = (dsub >= 0) && (dsub <= 128) && (first || key >= 128);
                const int di = dsub < 0 ? 0 : (dsub > 128 ? 128 : dsub);
                lg = valid ? lg + tb[di] : -1.0e30f;
            }
            s[i][j] = lg; mx = fmaxf(mx, lg);
        }
    mx = fmaxf(mx, __shfl_xor(mx, 16)); mx = fmaxf(mx, __shfl_xor(mx, 32));
    float l = 0.f;
#pragma unroll
    for (int i = 0; i < NB; ++i)
#pragma unroll
        for (int j = 0; j < 4; ++j) { const float p = __expf(s[i][j] - mx); s[i][j] = p; l += p; }
    l += __shfl_xor(l, 16); l += __shfl_xor(l, 32);
    f32x4 o[4];
#pragma unroll
    for (int nd = 0; nd < 4; ++nd) o[nd] = (f32x4){0.f, 0.f, 0.f, 0.f};
#pragma unroll
    for (int kb = 0; kb < NS / 2; ++kb) {
        u32x4 pa; pa.x = cvt_pk_bf16(s[2 * kb][0], s[2 * kb][1]); pa.y = cvt_pk_bf16(s[2 * kb][2], s[2 * kb][3]);
        pa.z = cvt_pk_bf16(s[2 * kb + 1][0], s[2 * kb + 1][1]); pa.w = cvt_pk_bf16(s[2 * kb + 1][2], s[2 * kb + 1][3]);
        const bf16x8 pf = __builtin_bit_cast(bf16x8, pa);
        int k0 = 32 * kb, k1 = 32 * kb + 16;
        if (MODE == 1) { k0 = 16 * (w + 2 * kb); const int b1 = w + 2 * kb + 1; k1 = 16 * (b1 > 15 ? 15 : b1); }
#pragma unroll
        for (int nd = 0; nd < 4; ++nd) {
            const LAS bf16_t* vp = Vt + (16 * nd + fr) * VT_PITCH + 4 * fq;
            const u32x2 v0 = *(const LAS u32x2*)(vp + k0), v1 = *(const LAS u32x2*)(vp + k1);
            u32x4 vb; vb.x = v0.x; vb.y = v0.y; vb.z = v1.x; vb.w = v1.y;
            o[nd] = __builtin_amdgcn_mfma_f32_16x16x32_bf16(pf, __builtin_bit_cast(bf16x8, vb), o[nd], 0, 0, 0);
        }
    }
    const float linv = 1.0f / l;
#pragma unroll
    for (int j = 0; j < 4; ++j) {
        const float li = __shfl(linv, 4 * fq + j);
        bf16_t* orow = Op + (long)(16 * w + 4 * fq + j) * o_stride;
#pragma unroll
        for (int nd = 0; nd < 4; ++nd) orow[16 * nd + fr] = (bf16_t)(cvt_pk_bf16(o[nd][j] * li, 0.f) & 0xffffu);
    }
    if (MODE == 1 && fq == 0) lsep[(long)qi * lse_stride] = mx + logf(l);
}
template <int MODE> __device__ __forceinline__ void attn_unit(LAS unsigned char* lds, const bf16_t* Qp, long q_stride, const bf16_t* Kp, const bf16_t* Vp, long kv_stride,
                                          int first, const float* qg1, const float* qg2, const float* rel_bias, int dil, int head,
                                          bf16_t* Op, long o_stride, float* lsep, long lse_stride, const int tid) {
    AttnIn r;
    attn_issue(r, Qp, q_stride, Kp, Vp, kv_stride, (MODE == 1) && !first, tid);
    attn_run<MODE>(lds, r, first, qg1, qg2, rel_bias, dil, head, Op, o_stride, lsep, lse_stride, tid, false, nullptr, 0, nullptr, nullptr, 0, false);
}
__device__ __forceinline__ void attn_decode_B(int u, int l, const bf16_t* qall, const bf16_t* kvb, const bf16_t* memkv,
                                              const bf16_t*& Qp, long& qs, const bf16_t*& Kp, const bf16_t*& Vp, long& kvs, bool& clampk) {
    if (u < 3072) {
        const int blk = u & 31, hh = (u >> 5) & 3, bg = u >> 7, g = bg % 3, b = bg / 3;
        const int dil = (g == 0) ? 1 : ((g == 1) ? 4 : 16), nper = 32 / dil, c = blk / nper, n = blk % nper, head = g * 4 + hh;
        const long tq0 = (long)b * SEQ + (long)(n * 128) * dil + c, tk0 = tq0 - 128L * dil;
        Qp = qall + tq0 * D + head * 64; qs = (long)dil * D; Kp = kvb + tk0 * KVW + head * 64; Vp = Kp + RW; kvs = (long)dil * KVW; clampk = (n == 0);
    } else {
        const int um = u - 3072, head = um & 3, tb = um >> 2; const long t0 = (long)tb * 128; const int b = (int)(t0 / SEQ);
        Qp = qall + t0 * D + RW + head * 64; qs = D; Kp = memkv + (size_t)(b * 256) * 2048 + l * 512 + head * 64; Vp = Kp + 256; kvs = 2048; clampk = false;
    }
}

constexpr int SC_TC = 32;
constexpr int SC_OPS = 0, SC_YB = 2 * SC_TC * 384 * 4, SC_CST = SC_YB + 16 * 512 * 4;
__device__ __forceinline__ void scan_fill(LAS float* opsd, const LAS float* cst, int ht, int tpos0, size_t tok0, int h, const bf16_t* proj, const bf16_t* lora) {
    const int htt = ht >> 4, hch = (ht & 15) * 4;
    const int tpos = tpos0 + htt; const size_t t_ = tok0 + tpos; const bool hp = tpos > 0;
    const bf16_t* p_ = proj + t_ * AIN + h * 64 + hch; const bf16_t* pq_ = p_ - (hp ? AIN : 0); const unsigned mk_ = hp ? 0xffffffffu : 0u;
    const u32x2 r_t = *(const u32x2*)p_, k_t = *(const u32x2*)(p_ + RW), v_t = *(const u32x2*)(p_ + 2 * RW);
    const u32x2 r_p = *(const u32x2*)pq_ & mk_, k_p = *(const u32x2*)(pq_ + RW) & mk_, v_p = *(const u32x2*)(pq_ + 2 * RW) & mk_;
    const bf16_t* l_ = lora + t_ * LORA_N + h * 64 + hch;
    const u32x2 pw = *(const u32x2*)l_, pa = *(const u32x2*)(l_ + RW);
    const f32x4 mur = *(const LAS f32x4*)(cst + hch), muk = *(const LAS f32x4*)(cst + 64 + hch), muv = *(const LAS f32x4*)(cst + 128 + hch),
                kks = *(const LAS f32x4*)(cst + 192 + hch), kav = *(const LAS f32x4*)(cst + 256 + hch);
    f32x4 rs, ks, vs, wv, av, kr; float ss = 0.f;
#pragma unroll
    for (int e = 0; e < 4; ++e) {
        const unsigned sh = e >> 1; const bool hi = e & 1;
        const float rt = hi ? bfhi(r_t[sh]) : bflo(r_t[sh]), rp = hi ? bfhi(r_p[sh]) : bflo(r_p[sh]);
        const float kt = hi ? bfhi(k_t[sh]) : bflo(k_t[sh]), kp = hi ? bfhi(k_p[sh]) : bflo(k_p[sh]);
        const float vt = hi ? bfhi(v_t[sh]) : bflo(v_t[sh]), vp = hi ? bfhi(v_p[sh]) : bflo(v_p[sh]);
        rs[e] = rt + mur[e] * (rp - rt); ks[e] = kt + muk[e] * (kp - kt); vs[e] = vt + muv[e] * (vp - vt);
        wv[e] = __expf(hi ? bfhi(pw[sh]) : bflo(pw[sh])); av[e] = hi ? bfhi(pa[sh]) : bflo(pa[sh]);
        kr[e] = ks[e] * kks[e]; ss += kr[e] * kr[e];
    }
    ss = allsum16(ss);
    const float inv = 1.0f / fmaxf(sqrtf(ss), 1e-12f);
    LAS float* o = opsd + htt * 384 + hch;
    f32x4 t0;
    *(LAS f32x4*)(o) = wv;
    t0 = kr * (-inv); *(LAS f32x4*)(o + 64) = t0;
    t0 = kr * inv * av; *(LAS f32x4*)(o + 128) = t0;
#pragma unroll
    for (int e = 0; e < 4; ++e) t0[e] = ks[e] * (1.0f + (av[e] - 1.0f) * kav[e]);
    *(LAS f32x4*)(o + 192) = t0;
    *(LAS f32x4*)(o + 256) = rs;
    *(LAS f32x4*)(o + 320) = vs;
}
__device__ __forceinline__ void scan_task(LAS unsigned char* lds, int b, int h, int half, const bf16_t* proj, const bf16_t* lora, bf16_t* yout,
                                          const float* mu, const float* kk_scale, const float* k_a, const int tid) {
    const int lane = tid & 63, w = tid >> 6;
    LAS float* ops = (LAS float*)(lds + SC_OPS); LAS float* ypart = (LAS float*)(lds + SC_YB); LAS float* cst = (LAS float*)(lds + SC_CST);
    __syncthreads();
    if (tid < 64) { cst[tid] = mu[h * 64 + tid]; cst[64 + tid] = mu[RW + h * 64 + tid]; cst[128 + tid] = mu[2 * RW + h * 64 + tid];
                    cst[192 + tid] = kk_scale[h * 64 + tid]; cst[256 + tid] = k_a[h * 64 + tid]; }
    const size_t tok0 = (size_t)b * SEQ;
    const int ht = tid - 256;
    __syncthreads();
    if (w >= 4) { scan_fill(ops, cst, ht, 0, tok0, h, proj, lora); scan_fill(ops + 16 * 384, cst, ht, 16, tok0, h, proj, lora); }
    const int kg = lane & 15, rA = (w & 3) * 8 + (lane >> 4), rB = rA + 4;
    const int vrowA = half * 32 + rA, vrowB = half * 32 + rB;
    f32x4 S = (f32x4){0.f, 0.f, 0.f, 0.f}, S2 = (f32x4){0.f, 0.f, 0.f, 0.f};
    __syncthreads();
    for (int c = 0; c < SEQ / SC_TC; ++c) {
        LAS float* opsb = ops + (c & 1) * (SC_TC * 384);
        LAS float* opsn = ops + ((c & 1) ^ 1) * (SC_TC * 384);
        for (int sub = 0; sub < 2; ++sub) {
            if (w < 4) {
                const LAS float* ob = opsb + (sub * 16) * 384 + kg * 4;
                const LAS float* vb = opsb + (sub * 16) * 384 + 320;
                f32x4 cw = *(const LAS f32x4*)(ob), cn = *(const LAS f32x4*)(ob + 64), cb = *(const LAS f32x4*)(ob + 128), ck = *(const LAS f32x4*)(ob + 192), cr = *(const LAS f32x4*)(ob + 256);
                float cvA = vb[vrowA], cvB = vb[vrowB];
                __builtin_amdgcn_s_setprio(3);
#pragma unroll 4
                for (int t16 = 0; t16 < 16; ++t16) {
                    const int tn = (t16 + 1) & 15;
                    const LAS float* nb_ = ob + tn * 384;
                    const f32x4 nw = *(const LAS f32x4*)(nb_), nn = *(const LAS f32x4*)(nb_ + 64), nb = *(const LAS f32x4*)(nb_ + 128), nk = *(const LAS f32x4*)(nb_ + 192), nr = *(const LAS f32x4*)(nb_ + 256);
                    const float nvA = vb[tn * 384 + vrowA], nvB = vb[tn * 384 + vrowB];
                    asm volatile("" ::: "memory");
                    f32x2 ta = S.lo * cn.lo; ta = S.hi * cn.hi + ta;
                    f32x2 tb = S2.lo * cn.lo; tb = S2.hi * cn.hi + tb;
                    float sa = ta.x + ta.y, sb = tb.x + tb.y;
                    sa = allsum16(sa); sb = allsum16(sb);
                    S = S * cw + (cb * sa + ck * cvA);
                    S2 = S2 * cw + (cb * sb + ck * cvB);
                    f32x2 ua = S.lo * cr.lo; ua = S.hi * cr.hi + ua;
                    f32x2 ub = S2.lo * cr.lo; ub = S2.hi * cr.hi + ub;
                    ypart[t16 * 512 + rA * 16 + kg] = ua.x + ua.y;
                    ypart[t16 * 512 + rB * 16 + kg] = ub.x + ub.y;
                    cw = nw; cn = nn; cb = nb; ck = nk; cr = nr; cvA = nvA; cvB = nvB;
                }
                __builtin_amdgcn_s_setprio(0);
            } else if (c + 1 < SEQ / SC_TC) {
                scan_fill(opsn + (sub * 16) * 384, cst, ht, (c + 1) * SC_TC + sub * 16, tok0, h, proj, lora);
            }
            __syncthreads();
            {
                const LAS float* yp_ = ypart + tid * 16;
                const f32x4 a = *(const LAS f32x4*)(yp_), b2 = *(const LAS f32x4*)(yp_ + 4), c2 = *(const LAS f32x4*)(yp_ + 8), d2 = *(const LAS f32x4*)(yp_ + 12);
                const float y = (((a[0] + a[1]) + (a[2] + a[3])) + ((b2[0] + b2[1]) + (b2[2] + b2[3]))) + (((c2[0] + c2[1]) + (c2[2] + c2[3])) + ((d2[0] + d2[1]) + (d2[2] + d2[3])));
                yout[(tok0 + c * SC_TC + sub * 16 + (tid >> 5)) * RW + h * 64 + half * 32 + (tid & 31)] = (bf16_t)(cvt_pk_bf16(y, 0.f) & 0xffffu);
            }
            __syncthreads();
        }
    }
}


__device__ __forceinline__ void conv_group(const __attribute__((address_space(4))) Params* PP, unsigned char* wreg, int l, int bits,
                                           LAS float* scr, int gw, int NGW, long gtid, long NGT, int lane) {
    const bool isA = l < 2; const int li = isA ? l : l - 2;
    if (bits & 1) {
        conv_T(PP->in[3] + (size_t)l * D * 2 * FF, D, 2 * FF, (bf16_t*)(wreg + W_FIN_PRE), PP->in[2] + l * D, 1, 0, scr, gw, NGW, lane);
        conv_T(PP->in[4] + (size_t)l * FF * D, FF, D, (bf16_t*)(wreg + W_FOUT_PRE), nullptr, 0, 0, scr, gw, NGW, lane);
    }
    if (bits & 2) {
        conv_T(PP->in[7] + (size_t)l * D * 2 * FF, D, 2 * FF, (bf16_t*)(wreg + W_FIN_POST), PP->in[6] + l * D, 1, 0, scr, gw, NGW, lane);
        conv_T(PP->in[8] + (size_t)l * FF * D, FF, D, (bf16_t*)(wreg + W_FOUT_POST), nullptr, 0, 0, scr, gw, NGW, lane);
    }
    if (bits & 4) {
        if (isA) conv_T(PP->in[13] + (size_t)li * D * AIN, D, AIN, (bf16_t*)(wreg + W_MIX_IN), PP->in[5] + l * D, 0, 0, scr, gw, NGW, lane);
        else conv_T(PP->in[26] + (size_t)li * D * D, D, D, (bf16_t*)(wreg + W_MIX_IN), PP->in[5] + l * D, 0, 0, scr, gw, NGW, lane);
    }
    if (bits & 8) {
        if (isA) conv_T(PP->in[25] + (size_t)li * D * D, D, D, (bf16_t*)(wreg + W_MIX_OUT), nullptr, 0, 0, scr, gw, NGW, lane);
        else conv_T(PP->in[28] + (size_t)li * 512 * D, 512, D, (bf16_t*)(wreg + W_MIX_OUT), nullptr, 0, 0, scr, gw, NGW, lane);
    }
    if ((bits & 16) && isA) {
        bf16_t* wl = (bf16_t*)(wreg + W_LORA);
        const float* wup = PP->in[16] + (size_t)li * 64 * RW; const float* aup = PP->in[18] + (size_t)li * 64 * RW; const float* gup = PP->in[19] + (size_t)li * 128 * RW;
        for (long i = gtid; i < (long)LORA_N * 256; i += NGT) {
            const int c = (int)(i >> 8), k = (int)(i & 255), seg = c / RW, cc = c - seg * RW; float v = 0.f;
            if (seg == 0) { if (k < 64) v = wup[k * RW + cc]; }
            else if (seg == 1) { if (k >= 64 && k < 128) v = aup[(k - 64) * RW + cc]; }
            else { if (k >= 128) v = gup[(k - 128) * RW + cc]; }
            wl[i] = (bf16_t)(cvt_pk_bf16(v, 0.f) & 0xffffu);
        }
    }
}

#define XB_TMO      128
#define XB_XCNT(j)  (256  + 64 * (j))
#define XB_XSUB(j)  (1280 + 64 * (j))
#define XB_XGEN(j)  (2304 + 64 * (j))
#define XB_TOP      3328
#define XB_TOPGEN   3392
#define XCD_BAR_WORDS 3456
#define XB_SPIN_CAP (1u << 18)
__device__ __forceinline__ unsigned xb_ld(unsigned* p)              { return __hip_atomic_load(p, __ATOMIC_RELAXED, __HIP_MEMORY_SCOPE_AGENT); }
__device__ __forceinline__ unsigned xb_add(unsigned* p, unsigned v) { return __hip_atomic_fetch_add(p, v, __ATOMIC_RELAXED, __HIP_MEMORY_SCOPE_AGENT); }
__device__ __forceinline__ unsigned xb_xcc_id() { return (unsigned)__builtin_amdgcn_s_getreg((3 << 11) | 20) & 0xFu; }
#define XB_SPIN(cond, bar) do { unsigned _sp = 0; while (cond) { __builtin_amdgcn_s_sleep(1); \
    if ((++_sp & 255u) == 0u) { if (xb_ld(&(bar)[XB_TMO])) break; if (_sp > XB_SPIN_CAP) { atomicAdd(&(bar)[XB_TMO], 1u); break; } } } } while (0)
struct XcdBarrier { unsigned* bar; unsigned x; volatile LAS unsigned* st; };
__device__ __forceinline__ XcdBarrier xcd_barrier_post(unsigned* bar, volatile LAS unsigned* st, const int tid) {
    XcdBarrier b; b.bar = bar; b.x = xb_xcc_id(); b.st = st;
    if (tid == 0) (void)xb_add(&bar[XB_XCNT(b.x)], 1u);
    return b;
}
__device__ __forceinline__ void xcd_barrier_complete(unsigned* bar, unsigned x, unsigned& nloc, unsigned& nx) {
    const unsigned G = gridDim.x * gridDim.y * gridDim.z;
    unsigned sum, cnt, mine, sp = 0u;
    for (;;) {
        sum = 0u; cnt = 0u; mine = 0u;
#pragma unroll
        for (unsigned j = 0; j < 16; ++j) { const unsigned c = xb_ld(&bar[XB_XCNT(j)]); sum += c; cnt += (c > 0u) ? 1u : 0u; mine = (j == x) ? c : mine; }
        if (sum == G) break;
        __builtin_amdgcn_s_sleep(1);
        if ((++sp & 255u) == 0u) { if (xb_ld(&bar[XB_TMO])) break; if (sp > XB_SPIN_CAP) { atomicAdd(&bar[XB_TMO], 1u); break; } }
    }
    nloc = mine > 0u ? mine : 1u; nx = cnt > 0u ? cnt : 1u;
}
__device__ __forceinline__ void xcd_barrier(const XcdBarrier& b, const int tid) {
    asm volatile("s_waitcnt vmcnt(0)" ::: "memory");
    __syncthreads();
    if (tid == 0) {
        unsigned* bar = b.bar;
        __builtin_amdgcn_s_waitcnt(0);
        unsigned nloc = b.st[0], nx = b.st[1];
        if (nloc == 0u) { xcd_barrier_complete(bar, b.x, nloc, nx); b.st[0] = nloc; b.st[1] = nx; }
        const unsigned old = xb_add(&bar[XB_XSUB(b.x)], 1u);
        const unsigned gen = old / nloc;
        if (old + 1u == (gen + 1u) * nloc) {
            __builtin_amdgcn_fence(__ATOMIC_RELEASE, "agent");
            asm volatile("s_waitcnt vmcnt(0)" ::: "memory");
            const unsigned og = xb_add(&bar[XB_TOP], 1u);
            const unsigned tg = og / nx;
            if (og + 1u == (tg + 1u) * nx) xb_add(&bar[XB_TOPGEN], 1u);
            else XB_SPIN(xb_ld(&bar[XB_TOPGEN]) == tg, bar);
            __builtin_amdgcn_fence(__ATOMIC_ACQUIRE, "agent");
            xb_add(&bar[XB_XGEN(b.x)], 1u);
            asm volatile("s_waitcnt vmcnt(0)" ::: "memory");
        } else {
            XB_SPIN(xb_ld(&bar[XB_XGEN(b.x)]) == gen, bar);
            __builtin_amdgcn_fence(__ATOMIC_ACQUIRE, "agent");
            asm volatile("s_waitcnt vmcnt(0)" ::: "memory");
        }
    }
    __syncthreads();
}

__global__ void __launch_bounds__(512, 2) fwd_kernel(Params P) {
    extern __shared__ __attribute__((aligned(16))) unsigned char lds_raw[];
    LAS unsigned char* lds = (LAS unsigned char*)lds_raw;
#if MK_SINGLE
    volatile LAS unsigned* misc = (volatile LAS unsigned*)(lds + MISC_OFF);
    if (threadIdx.x < 2) misc[threadIdx.x] = 0u;
    __syncthreads();
    (void)xcd_barrier_post((unsigned*)(P.ws + WS_BAR), misc, (int)threadIdx.x);
#endif
    const int wave_s = __builtin_amdgcn_readfirstlane((int)threadIdx.x >> 6);
    for (int it = P.ph_lo * 2; it < P.ph_hi * 2; ++it) {
        const int ph = it >> 1;
        if ((it & 1) && !((DUPMASK >> (ph % 12)) & 1)) continue;
        int tid = (wave_s << 6) | (int)__builtin_amdgcn_mbcnt_hi(~0u, __builtin_amdgcn_mbcnt_lo(~0u, 0u)); asm volatile("" : "+v"(tid));
        int bx = blockIdx.x; asm volatile("" : "+s"(bx));
        int G = gridDim.x; asm volatile("" : "+s"(G));
        const __attribute__((address_space(4))) Params* PP = (const __attribute__((address_space(4))) Params*)__builtin_amdgcn_kernarg_segment_ptr(); asm volatile("" : "+s"(PP));
        unsigned char* ws = PP->ws; float* X = PP->out;
#define lane (tid & 63)
#define wave (tid >> 6)
#define gw (bx * 8 + (tid >> 6))
#define NGW (G * 8)
#define gtid ((long)bx * 512 + tid)
#define NGT ((long)G * 512)
        float* ssq = (float*)(ws + WS_SSQ); float* memssq = (float*)(ws + WS_MEMSSQ); float* lse = (float*)(ws + WS_LSE);
        bf16_t* memb = (bf16_t*)(ws + WS_MEMB); bf16_t* memkv = (bf16_t*)(ws + WS_MEMKV);
        bf16_t* xb = (bf16_t*)(ws + WS_XB); bf16_t* yscan = xb; bf16_t* aprep = (bf16_t*)(ws + WS_XB + 48 * MiB);
        bf16_t* hbuf = (bf16_t*)(ws + WS_H); bf16_t* proj = hbuf; bf16_t* qall = hbuf; bf16_t* catb = (bf16_t*)(ws + WS_H + 64 * MiB);
        bf16_t* lora = (bf16_t*)(ws + WS_LORA); bf16_t* kvb = lora; bf16_t* og = (bf16_t*)(ws + WS_LORA + 96 * MiB); bf16_t* wmemkv = lora;
        bf16_t* cat = (bf16_t*)(ws + WS_CAT);
        unsigned char* wreg = ws + WS_W;
#define scr ((LAS float*)(lds + (tid >> 6) * 16384))
        const int l = ph / 12, p = ph % 12;
        const bool isA = l < 2; const int li = isA ? l : l - 2;
        const bool empty = (!isA && (p == 6 || p == 7)) || (p == 11 && l != 1) || (p == 0 && l != 0);
        if (empty) continue;
        if (p == 0) {
            if (l == 0) {
                for (int m = gw; m < T; m += NGW) {
                    const f32x4* xr = (const f32x4*)(PP->in[0] + (size_t)m * D) + lane; float s = 0.f;
#pragma unroll
                    for (int j = 0; j < 4; ++j) { const f32x4 v = xr[64 * j]; s += (v[0] * v[0] + v[1] * v[1]) + (v[2] * v[2] + v[3] * v[3]);
                        *((f32x4*)(X + (size_t)m * D) + lane + 64 * j) = v;
                        u32x2 o; o.x = cvt_pk_bf16(v[0], v[1]); o.y = cvt_pk_bf16(v[2], v[3]); *((u32x2*)(xb + (size_t)m * D) + lane + 64 * j) = o; }
#pragma unroll
                    for (int o = 1; o < 64; o <<= 1) s += __shfl_xor(s, o);
                    if (lane < 16) ssq[(size_t)m * 16 + lane] = (lane == 0) ? s : 0.f;
                }
                for (int m = gw; m < 2048; m += NGW) {
                    const f32x4* xr = (const f32x4*)(PP->in[1] + (size_t)m * D) + lane; float s = 0.f;
#pragma unroll
                    for (int j = 0; j < 4; ++j) { const f32x4 v = xr[64 * j]; s += (v[0] * v[0] + v[1] * v[1]) + (v[2] * v[2] + v[3] * v[3]);
                        u32x2 o; o.x = cvt_pk_bf16(v[0], v[1]); o.y = cvt_pk_bf16(v[2], v[3]); *((u32x2*)(memb + (size_t)m * D) + lane + 64 * j) = o; }
#pragma unroll
                    for (int o = 1; o < 64; o <<= 1) s += __shfl_xor(s, o);
                    if (lane < 16) memssq[(size_t)m * 16 + lane] = (lane == 0) ? s : 0.f;
                }
                for (int q = 0; q < 4; ++q)
                    conv_T(PP->in[10] + (size_t)q * D * 512, D, 512, wmemkv, PP->in[9] + q * D, 0, q * 512, scr, gw, NGW, lane);
            }
            conv_group(PP, wreg, 0, 1 | 4 | 8 | 16, scr, gw, NGW, gtid, NGT, lane);
        } else if (p == 1 || p == 2 || p == 3 || p == 5 || p == 8 || p == 9 || p == 10 || p == 11) {
            if (p == 5 && !isA) {
                if (l == 2) { conv_group(PP, wreg, 2, 2, scr, gw, NGW, gtid, NGT, lane);
                              conv_group(PP, wreg, 3, 1 | 4, scr, gw, NGW, gtid, NGT, lane); }
                if (l == 3) conv_group(PP, wreg, 3, 2, scr, gw, NGW, gtid, NGT, lane);
                for (long i0 = gtid; i0 < (long)T * 64; i0 += 4 * NGT) {
                    float l0[4], l1[4], l2[4]; u32x2 a[4], b[4], c[4];
#pragma unroll
                    for (int u = 0; u < 4; ++u) { const long i = i0 + u * NGT; const long t = i >> 6; const int hh = (int)(i >> 4) & 3, d = ((int)i & 15) * 4;
                        l0[u] = lse[t * 12 + hh]; l1[u] = lse[t * 12 + 4 + hh]; l2[u] = lse[t * 12 + 8 + hh];
                        a[u] = *(const u32x2*)(og + t * RW + hh * 64 + d); b[u] = *(const u32x2*)(og + t * RW + (4 + hh) * 64 + d); c[u] = *(const u32x2*)(og + t * RW + (8 + hh) * 64 + d); }
#pragma unroll
                    for (int u = 0; u < 4; ++u) { const long i = i0 + u * NGT; const long t = i >> 6; const int hh = (int)(i >> 4) & 3, d = ((int)i & 15) * 4;
                        const float mx = fmaxf(l0[u], fmaxf(l1[u], l2[u])); float w0 = __expf(l0[u] - mx), w1 = __expf(l1[u] - mx), w2 = __expf(l2[u] - mx);
                        const float inv = 1.0f / (w0 + w1 + w2); w0 *= inv; w1 *= inv; w2 *= inv;
                        u32x2 o; o.x = cvt_pk_bf16(w0 * bflo(a[u].x) + w1 * bflo(b[u].x) + w2 * bflo(c[u].x), w0 * bfhi(a[u].x) + w1 * bfhi(b[u].x) + w2 * bfhi(c[u].x));
                        o.y = cvt_pk_bf16(w0 * bflo(a[u].y) + w1 * bflo(b[u].y) + w2 * bflo(c[u].y), w0 * bfhi(a[u].y) + w1 * bfhi(b[u].y) + w2 * bfhi(c[u].y));
                        *(u32x2*)(catb + t * 512 + hh * 64 + d) = o; }
                }
            } else {
                if (p == 9 && l == 1)
                    conv_T(PP->in[30], D, KVW, (bf16_t*)(wreg + W_MIX_IN), PP->in[29], 0, 0, scr, gw, NGW, lane);
                if (p == 9 && l == 0) conv_group(PP, wreg, 1, 8, scr, gw, NGW, gtid, NGT, lane);
                if (p == 9 && l == 2) conv_group(PP, wreg, 3, 8, scr, gw, NGW, gtid, NGT, lane);
                if (p == 2 && l == 2) conv_group(PP, wreg, 2, 4 | 8, scr, gw, NGW, gtid, NGT, lane);
                const int nrep = (p == 3 && l == 0 && bx >= G / 2) ? 2 : 1;
                for (int rep = 0; rep < nrep; ++rep) {
                    const bf16_t* gA = xb; const bf16_t* gB = (const bf16_t*)wreg; int gM = T, gN = D, gK = D;
                    int e_mode = 2, e_perm = 1, e_ldo = 0; const float* e_ssq_in = nullptr; bf16_t* e_ob = nullptr; float e_scale = 0.f; float* e_ssq_out = nullptr;
                    const float* e_w0 = nullptr; const float* e_a0 = nullptr;
                    if (rep == 1) { gA = memb; gB = wmemkv; gM = 2048; gN = 2048; gK = D; e_ssq_in = memssq; e_ob = memkv; e_ldo = 2048; }
                    else if (p == 1) { gB = (bf16_t*)(wreg + W_FIN_PRE); gN = 2 * FF; e_mode = 0; e_ssq_in = ssq + 0; e_ob = hbuf; e_ldo = FF; }
                    else if (p == 2) { gA = hbuf; gB = (bf16_t*)(wreg + W_FOUT_PRE); gK = FF; e_mode = 1; e_perm = 0; e_scale = 0.5f; e_ob = xb; e_ssq_out = ssq + 0; }
                    else if (p == 3) { gB = (bf16_t*)(wreg + W_MIX_IN); gN = isA ? AIN : D; e_ssq_in = ssq + 0; e_ob = hbuf; e_ldo = isA ? AIN : D; }
                    else if (p == 5) { gA = aprep; gB = (bf16_t*)(wreg + W_LORA); gN = LORA_N; gK = 256; e_mode = 3; e_ob = lora; e_ldo = LORA_N; e_w0 = PP->in[15] + li * RW; e_a0 = PP->in[17] + li * RW; }
                    else if (p == 8) { gA = isA ? cat : catb; gB = (bf16_t*)(wreg + W_MIX_OUT); gK = isA ? D : 512; e_mode = 1; e_perm = 0; e_scale = 1.0f; e_ob = xb; e_ssq_out = ssq + 0; }
                    else if (p == 9) { gB = (bf16_t*)(wreg + W_FIN_POST); gN = 2 * FF; e_mode = 0; e_ssq_in = ssq + 0; e_ob = hbuf; e_ldo = FF; }
                    else if (p == 10) { gA = hbuf; gB = (bf16_t*)(wreg + W_FOUT_POST); gK = FF; e_mode = 1; e_perm = 0; e_scale = 0.5f; e_ob = xb; e_ssq_out = ssq + 0; }
                    else { gB = (bf16_t*)(wreg + W_MIX_IN); gN = KVW; e_ssq_in = ssq + 0; e_ob = kvb; e_ldo = KVW; }
                    const pg8::Gemm g{gA, gB, gM, gN, gK};
                    const pg8::Epi E{e_mode, e_perm, (const gfloat*)e_ssq_in, (gbf16*)e_ob, e_ldo, (gfloat*)X, (const gfloat*)e_w0, (const gfloat*)e_a0};
                    if (p == 9 && l == 1) { __threadfence(); }
                    pg8::StaticOrder S; if (rep == 1) S.init(g.M, g.N, G / 2, bx - G / 2); else S.init(g.M, g.N, G, bx);
                    __syncthreads();
                    int tg = tid; asm volatile("" : "+v"(tg));
                    const float e_scale_s = __int_as_float(__builtin_amdgcn_readfirstlane(__float_as_int(e_scale)));
                    pg8::gemm_phase(lds, g, S, E, e_scale_s, (gfloat*)e_ssq_out, tg);
                    __syncthreads();
                }
            }
        } else if (p == 4) {
            if (isA) {
                const float* mu = PP->in[14] + (size_t)li * 2560 + 2304;
                const int j = ((int)gtid & 63) * 4;
                const f32x4 m4 = *(const f32x4*)(mu + j);
                for (long i0 = gtid; i0 < (long)T * 64; i0 += 4 * NGT) {
                    u32x2 a[4], b[4];
#pragma unroll
                    for (int u = 0; u < 4; ++u) { const long t = (i0 + u * NGT) >> 6;
                        a[u] = *(const u32x2*)(proj + t * AIN + 2304 + j);
                        const bool hp = (t & (SEQ - 1)) != 0; const unsigned mk = hp ? 0xffffffffu : 0u; b[u] = *(const u32x2*)(proj + (t - (hp ? 1 : 0)) * AIN + 2304 + j) & mk; }
#pragma unroll
                    for (int u = 0; u < 4; ++u) { const long t = (i0 + u * NGT) >> 6;
                        float v[4]; v[0] = bflo(a[u].x) + m4[0] * (bflo(b[u].x) - bflo(a[u].x)); v[1] = bfhi(a[u].x) + m4[1] * (bfhi(b[u].x) - bfhi(a[u].x));
                        v[2] = bflo(a[u].y) + m4[2] * (bflo(b[u].y) - bflo(a[u].y)); v[3] = bfhi(a[u].y) + m4[3] * (bfhi(b[u].y) - bfhi(a[u].y));
                        if (j < 64) {
#pragma unroll
                            for (int e = 0; e < 4; ++e) v[e] = 1.0f - 2.0f * __builtin_amdgcn_rcpf(1.0f + __expf(2.0f * v[e]));
                        } else if (j >= 128) {
#pragma unroll
                            for (int e = 0; e < 4; ++e) v[e] = sigmoidf_(v[e]);
                        }
                        u32x2 o; o.x = cvt_pk_bf16(v[0], v[1]); o.y = cvt_pk_bf16(v[2], v[3]);
                        *(u32x2*)(aprep + t * 256 + j) = o; }
                }
            }
            if (!isA) {
                AttnIn r;
                { const bf16_t* Qp; const bf16_t* Kp; const bf16_t* Vp; long qs, kvs; bool ck;
                  attn_decode_B(bx, l, qall, kvb, memkv, Qp, qs, Kp, Vp, kvs, ck); attn_issue(r, Qp, qs, Kp, Vp, kvs, ck, tid); }
                for (int u = bx; u < 4096; u += G) {
                    int tidu = tid; asm volatile("" : "+v"(tidu));
                    const int un = u + G; const bool hn = un < 4096;
                    const bf16_t* nQ = qall; const bf16_t* nK = kvb; const bf16_t* nV = kvb; long nqs = 0, nkvs = 0; bool nck = false;
                    if (hn) attn_decode_B(un, l, qall, kvb, memkv, nQ, nqs, nK, nV, nkvs, nck);
                    if (u < 3072) {
                        const int blk = u & 31, hh = (u >> 5) & 3, bg = u >> 7, g = bg % 3, b = bg / 3;
                        const int dil = (g == 0) ? 1 : ((g == 1) ? 4 : 16), nper = 32 / dil, c = blk / nper, n = blk % nper, head = g * 4 + hh;
                        const long tq0 = (long)b * SEQ + (long)(n * 128) * dil + c;
                        attn_run<1>(lds, r, n > 0 ? 1 : 0, PP->in[27] + li * 64, PP->in[31], PP->in[32], dil, head, og + tq0 * RW + head * 64, (long)dil * RW, lse + tq0 * 12 + head, (long)dil * 12, tidu,
                                    hn, nQ, nqs, nK, nV, nkvs, nck);
                    } else {
                        const int um = u - 3072, head = um & 3, tb = um >> 2; const long t0 = (long)tb * 128;
                        attn_run<0>(lds, r, 1, PP->in[11] + l * 64, PP->in[12] + l * 64, nullptr, 1, 0, catb + t0 * 512 + 256 + head * 64, 512, nullptr, 0, tidu,
                                    hn, nQ, nqs, nK, nV, nkvs, nck);
                    }
                }
            }
        } else if (p == 6) {
            if (bx >= 192) {
                const int sub = bx - 192, nsub = G - 192;
                for (int um = sub; um < 1024; um += nsub) {
                    int tidu = tid; asm volatile("" : "+v"(tidu));
                    const int head = um & 3, tb = um >> 2; const long t0 = (long)tb * 128; const int b = (int)(t0 / SEQ);
                    attn_unit<0>(lds, proj + t0 * AIN + 2560 + head * 64, AIN, memkv + (size_t)(b * 256) * 2048 + l * 512 + head * 64, memkv + (size_t)(b * 256) * 2048 + l * 512 + 256 + head * 64, 2048,
                                 1, PP->in[11] + l * 64, PP->in[12] + l * 64, nullptr, 1, 0, cat + t0 * D + RW + head * 64, D, nullptr, 0, tidu);
                }
                __syncthreads();
                const int gw2 = sub * 8 + wave, NGW2 = nsub * 8; const long gtid2 = (long)sub * 512 + tid, NGT2 = (long)nsub * 512;
                conv_group(PP, wreg, l, 2, scr, gw2, NGW2, gtid2, NGT2, lane);
                conv_group(PP, wreg, l + 1, (l == 0) ? (1 | 4 | 16) : 1, scr, gw2, NGW2, gtid2, NGT2, lane);
            }
            for (int task = bx; task < 192; task += G) {
                const int half = (task >> 3) & 1, bh = (task & 7) + 8 * (task >> 4);
                const int b = bh / 12, h = bh % 12;
                scan_task(lds, b, h, half, proj, lora, yscan, PP->in[14] + (size_t)li * 2560, PP->in[20] + li * RW, PP->in[21] + li * RW, tid);
            }
        } else if (p == 7) {
            const float* mu = PP->in[14] + (size_t)li * 2560; const float* k_a = PP->in[21] + li * RW; const float* r_k = PP->in[22] + li * RW;
            const float* lng = PP->in[23] + li * RW; const float* lnb = PP->in[24] + li * RW;
            const int q3 = gw % 3, tstep = NGW / 3; const int col = q3 * 256 + lane * 4;
            const f32x4 mr = *(const f32x4*)(mu + col), mk = *(const f32x4*)(mu + RW + col), mv = *(const f32x4*)(mu + 2 * RW + col);
            const f32x4 ka = *(const f32x4*)(k_a + col), rk4 = *(const f32x4*)(r_k + col), g4 = *(const f32x4*)(lng + col), b4 = *(const f32x4*)(lnb + col);
#define POST_LOAD(T_, S) \
                const bool hp##S = ((T_) & (SEQ - 1)) != 0; \
                const u32x2 yv##S = *(const u32x2*)(yscan + (T_) * RW + col); \
                const bf16_t* pp##S = proj + (T_) * AIN + col; \
                const u32x2 rt##S = *(const u32x2*)pp##S, kt##S = *(const u32x2*)(pp##S + RW), vt##S = *(const u32x2*)(pp##S + 2 * RW); \
                const bf16_t* pq##S = pp##S - (hp##S ? AIN : 0); const unsigned msk##S = hp##S ? 0xffffffffu : 0u; \
                const u32x2 rp##S = *(const u32x2*)pq##S & msk##S, kp##S = *(const u32x2*)(pq##S + RW) & msk##S, vp##S = *(const u32x2*)(pq##S + 2 * RW) & msk##S; \
                const u32x2 av##S = *(const u32x2*)(lora + (T_) * LORA_N + RW + col), gv##S = *(const u32x2*)(lora + (T_) * LORA_N + 2 * RW + col);
#define POST_COMP(T_, S) { \
                float y[4] = {bflo(yv##S.x), bfhi(yv##S.x), bflo(yv##S.y), bfhi(yv##S.y)}; \
                const float r0[4] = {bflo(rt##S.x), bfhi(rt##S.x), bflo(rt##S.y), bfhi(rt##S.y)}, r1[4] = {bflo(rp##S.x), bfhi(rp##S.x), bflo(rp##S.y), bfhi(rp##S.y)}; \
                const float k0[4] = {bflo(kt##S.x), bfhi(kt##S.x), bflo(kt##S.y), bfhi(kt##S.y)}, k1[4] = {bflo(kp##S.x), bfhi(kp##S.x), bflo(kp##S.y), bfhi(kp##S.y)}; \
                const float v0[4] = {bflo(vt##S.x), bfhi(vt##S.x), bflo(vt##S.y), bfhi(vt##S.y)}, v1[4] = {bflo(vp##S.x), bfhi(vp##S.x), bflo(vp##S.y), bfhi(vp##S.y)}; \
                const float aa[4] = {bflo(av##S.x), bfhi(av##S.x), bflo(av##S.y), bfhi(av##S.y)}, gg[4] = {bflo(gv##S.x), bfhi(gv##S.x), bflo(gv##S.y), bfhi(gv##S.y)}; \
                float mean = allsum16((y[0] + y[1]) + (y[2] + y[3])) * (1.0f / 64.0f); \
                float var = 0.f, sb = 0.f, vs[4]; \
                _Pragma("unroll") for (int e = 0; e < 4; ++e) { y[e] -= mean; var += y[e] * y[e]; \
                    const float rs = r0[e] + mr[e] * (r1[e] - r0[e]), ks = k0[e] + mk[e] * (k1[e] - k0[e]); vs[e] = v0[e] + mv[e] * (v1[e] - v0[e]); \
                    sb += rs * ks * (1.0f + (aa[e] - 1.0f) * ka[e]) * rk4[e]; } \
                var = allsum16(var) * (1.0f / 64.0f); sb = allsum16(sb); \
                const float rstd = rsqrtf(var + 64e-5f); \
                float o[4]; \
                _Pragma("unroll") for (int e = 0; e < 4; ++e) o[e] = (y[e] * rstd * g4[e] + b4[e] + sb * vs[e]) * gg[e]; \
                u32x2 ow; ow.x = cvt_pk_bf16(o[0], o[1]); ow.y = cvt_pk_bf16(o[2], o[3]); \
                *(u32x2*)(cat + (T_) * D + col) = ow; }
            for (long t = (gw < 3 * tstep) ? gw / 3 : T; t < T; t += 2 * tstep) {
                const long tB = t + tstep; const bool hasB = tB < T; const long tBc = hasB ? tB : t;
                POST_LOAD(t, A)
                POST_LOAD(tBc, B)
                POST_COMP(t, A)
                if (hasB) POST_COMP(tB, B)
            }
#undef POST_LOAD
#undef POST_COMP
        }
#if MK_SINGLE
        if (it + 2 < P.ph_hi * 2) { if (it == 0) cg::this_grid().sync(); else { XcdBarrier xb_; xb_.bar = (unsigned*)(ws + WS_BAR); xb_.x = xb_xcc_id(); xb_.st = (volatile LAS unsigned*)(lds + MISC_OFF); xcd_barrier(xb_, tid); } }
#endif
    }
}

#undef lane
#undef wave
#undef gw
#undef NGW
#undef gtid
#undef NGT
#undef scr
extern "C" void kernel_launch(void* const* d_in, const int* in_sizes, int n_in, void* d_out, int out_size, void* d_ws, size_t ws_size, hipStream_t stream) {
    static int ready = 0;
    if (!ready) {
        if (n_in != 33 || out_size != T * D || ws_size < WS_END) { fprintf(stderr, "kernel_launch: unexpected shapes (n_in %d out %d ws %zu)\n", n_in, out_size, ws_size); ready = -1; return; }
        if (hipFuncSetAttribute((const void*)fwd_kernel, hipFuncAttributeMaxDynamicSharedMemorySize, LDS_BYTES) != hipSuccess) { fprintf(stderr, "kernel_launch: hipFuncSetAttribute failed\n"); ready = -1; return; }
        int per_cu = 0;
        hipOccupancyMaxActiveBlocksPerMultiprocessor(&per_cu, (const void*)fwd_kernel, 512, LDS_BYTES);
        if (per_cu < 1) fprintf(stderr, "kernel_launch: occupancy query says %d blocks per CU\n", per_cu);
        (void)hipGetLastError();
        ready = 1;
    }
    if (ready < 0) return;
    Params p{};
    for (int i = 0; i < 33; ++i) p.in[i] = (const float*)d_in[i];
    p.out = (float*)d_out; p.ws = (unsigned char*)d_ws;
    const int grid = 256;
#if MK_SINGLE
    hipMemsetAsync((char*)d_ws + WS_BAR, 0, 16384, stream);
    p.ph_lo = 0; p.ph_hi = 48;
    void* args[] = {&p};
    hipError_t e = hipLaunchCooperativeKernel((const void*)fwd_kernel, dim3(grid), dim3(512), args, LDS_BYTES, stream);
    if (e != hipSuccess) fprintf(stderr, "cooperative launch failed: %s\n", hipGetErrorString(e));
#else
    for (int ph = 0; ph < 48; ++ph) {
        const int l = ph / 12, q = ph % 12; const bool isA = l < 2;
        if ((!isA && (q == 6 || q == 7)) || (q == 11 && l != 1) || (q == 0 && l != 0)) continue;
        p.ph_lo = ph; p.ph_hi = ph + 1;
        hipLaunchKernelGGL(fwd_kernel, dim3(grid), dim3(512), LDS_BYTES, stream, p);
    }
#endif
}
```

```cpp
#include <hip/hip_runtime.h>
#include <hip/hip_cooperative_groups.h>
#include <cstdio>
namespace cg = cooperative_groups;

#ifndef MK_SINGLE
#define MK_SINGLE 1
#endif

#define LAS __attribute__((address_space(3)))
typedef unsigned short bf16_t;
typedef short bf16x8 __attribute__((ext_vector_type(8)));
typedef short bf16x4 __attribute__((ext_vector_type(4)));
typedef float f32x4 __attribute__((ext_vector_type(4)));
typedef float f32x2 __attribute__((ext_vector_type(2)));
typedef unsigned u32x4 __attribute__((ext_vector_type(4)));
typedef unsigned u32x2 __attribute__((ext_vector_type(2)));
#define GAS __attribute__((address_space(1)))
typedef GAS float gfloat;
typedef GAS unsigned short gbf16;

constexpr int T = 32768, D = 1024, FF = 2816, SEQ = 4096;
constexpr int AIN = 2816, RW = 768, LORA_N = 2304, KVW = 1536;
constexpr float NORM_EPS = 1e-6f;
constexpr size_t MiB = 1u << 20;
constexpr size_t WS_SSQ = 0;
constexpr size_t WS_MEMSSQ = 3584 * 1024;
constexpr size_t WS_LSE = 2 * MiB;
constexpr size_t WS_BAR = 3840 * 1024;
constexpr size_t WS_MEMB = 4 * MiB;
constexpr size_t WS_MEMKV = 8 * MiB;
constexpr size_t WS_W = 16 * MiB;
constexpr size_t WS_XB = 60 * MiB;
constexpr size_t WS_H = 124 * MiB;
constexpr size_t WS_LORA = 300 * MiB;
constexpr size_t WS_CAT = 444 * MiB;
constexpr size_t WS_END = 508 * MiB;
constexpr size_t W_FIN_PRE = 0, W_FOUT_PRE = 11 * MiB, W_FIN_POST = 16 * MiB + 512 * 1024, W_FOUT_POST = 27 * MiB + 512 * 1024,
                 W_MIX_IN = 33 * MiB, W_MIX_OUT = 38 * MiB + 512 * 1024, W_LORA = 40 * MiB + 512 * 1024;
constexpr int LDS_BYTES = 147456, MISC_OFF = 147456 - 64;
#ifndef EXP_DELAY
#define EXP_DELAY 0
#endif
#ifndef DUPMASK
#define DUPMASK 0
#endif

__device__ __forceinline__ unsigned cvt_pk_bf16(float lo, float hi) { unsigned r; asm volatile("v_cvt_pk_bf16_f32 %0, %1, %2" : "=v"(r) : "v"(lo), "v"(hi)); return r; }
__device__ __forceinline__ float bflo(unsigned u) { return __uint_as_float(u << 16); }
__device__ __forceinline__ float bfhi(unsigned u) { return __uint_as_float(u & 0xffff0000u); }
__device__ __forceinline__ float bf1(bf16_t v) { return __uint_as_float((unsigned)v << 16); }
__device__ __forceinline__ float sigmoidf_(float x) { return __builtin_amdgcn_rcpf(1.0f + __expf(-x)); }
__device__ __forceinline__ float xsum_rows(float s) {
    const auto r = __builtin_amdgcn_permlane16_swap(__float_as_uint(s), __float_as_uint(s), false, false);
    s = __uint_as_float(r[0]) + __uint_as_float(r[1]);
    const auto q = __builtin_amdgcn_permlane32_swap(__float_as_uint(s), __float_as_uint(s), false, false);
    return __uint_as_float(q[0]) + __uint_as_float(q[1]);
}
template <int CTRL> __device__ __forceinline__ float dpp_f(float v) { return __int_as_float(__builtin_amdgcn_update_dpp(0, __float_as_int(v), CTRL, 0xf, 0xf, false)); }
__device__ __forceinline__ float allsum16(float v) {
    v += dpp_f<0x128>(v);
    v += dpp_f<0x124>(v);
    v += dpp_f<0x122>(v);
    v += dpp_f<0x121>(v);
    return v;
}

namespace pg8 {
constexpr int BM = 256, BK = 64, HALF = 128, HTB = HALF * BK * 2, STAGE_BYTES = 8 * HTB, NXCD = 8, WGM = 8;
__device__ __forceinline__ int lds_byte(int r, int c) { const int st = (r >> 4) * 2 + (c >> 5), rr = r & 15, cc = c & 31, ob = rr * 64 + cc * 2; return st * 1024 + (ob ^ (((ob >> 9) & 1) << 5)); }
__device__ __forceinline__ void stage_rc(int b, int& R, int& C) { const int st = b / 1024, sb = b % 1024, swz = sb ^ (((sb >> 9) & 1) << 5); R = (st >> 1) * 16 + swz / 64; C = (st & 1) * 32 + (swz % 64) / 2; }
__device__ __forceinline__ int perm32(int rho) { const int n = rho >> 4, i = rho & 15; return 8 * (i >> 2) + 4 * n + (i & 3); }
struct Unit { int pm, pn; };
struct Gemm { const bf16_t* A; const bf16_t* Bt; int M, N, K; };
struct StaticOrder {
    int nM, nN, nwg, G, c;
    __device__ void init(int M, int N, int G_, int c_) { nM = M / BM; nN = N / BM; nwg = nM * nN; G = G_; c = c_; }
    __device__ bool next(int i, Unit& u) const {
        const long L = (long)i * G + c; if (L >= nwg) return false;
        int wgid = (int)L; { const int q = nwg / NXCD, r = nwg % NXCD, xcd = wgid % NXCD, off = wgid / NXCD; wgid = (xcd < r ? xcd * (q + 1) : r * (q + 1) + (xcd - r) * q) + off; }
        const int nig = WGM * nN, gid = wgid / nig, fm = gid * WGM, gsz = (nM - fm) < WGM ? (nM - fm) : WGM;
        u.pm = fm + ((wgid % nig) % gsz); u.pn = (wgid % nig) / gsz; return true;
    }
};

struct Epi {
    int mode, perm;
    const gfloat* ssq_in; gbf16* ob; int ldo;
    gfloat* x;
    const gfloat* w0; const gfloat* a0;
    template <int NR> __device__ __forceinline__ void rstdN(float (&rs)[NR], int rowbase, int fq) const {
        const GAS f32x4* bp = (const GAS f32x4*)(ssq_in + (size_t)rowbase * 16 + 4 * fq);
        f32x4 p[NR];
#pragma unroll
        for (int m = 0; m < NR; ++m) p[m] = bp[m * 64];
        asm volatile("" :: "v"(bp));
#pragma unroll
        for (int m = 0; m < NR; ++m) {
            float s = (p[m][0] + p[m][1]) + (p[m][2] + p[m][3]);
            s = xsum_rows(s);
            rs[m] = rsqrtf(s * (1.0f / 1024.0f) + NORM_EPS);
        }
    }
    __device__ __forceinline__ void rstd8(float (&rs)[2][4], int row0, int fq) const {
        const GAS f32x4* b0 = (const GAS f32x4*)(ssq_in + (size_t)row0 * 16 + 4 * fq);
        const GAS f32x4* b1 = (const GAS f32x4*)(ssq_in + (size_t)(row0 + HALF) * 16 + 4 * fq);
        f32x4 p[2][4];
#pragma unroll
        for (int m = 0; m < 4; ++m) { p[0][m] = b0[m * 64]; p[1][m] = b1[m * 64]; }
        asm volatile("" :: "v"(b0), "v"(b1));
#pragma unroll
        for (int ai = 0; ai < 2; ++ai)
#pragma unroll
            for (int m = 0; m < 4; ++m) {
                float s = (p[ai][m][0] + p[ai][m][1]) + (p[ai][m][2] + p[ai][m][3]);
                s = xsum_rows(s);
                rs[ai][m] = rsqrtf(s * (1.0f / 1024.0f) + NORM_EPS);
            }
    }
    __device__ __forceinline__ float row_rstd(int row, int fq) const {
        const f32x4 p = *(const GAS f32x4*)(ssq_in + (size_t)row * 16 + 4 * fq);
        float s = (p[0] + p[1]) + (p[2] + p[3]);
        s += __shfl_xor(s, 16); s += __shfl_xor(s, 32);
        return rsqrtf(s * (1.0f / 1024.0f) + NORM_EPS);
    }
    template <int KIND> __device__ __forceinline__ void epi_bf16(const f32x4 (&acc)[2][2][4][2], const Unit& u, int row0, int wc, int fq) const {
        const int colt = u.pn * BM + wc * 32 + 8 * fq;
        const int seg = (KIND == 1) ? 0 : ((KIND == 2) ? 1 : 2);
        f32x4 bv[2][2];
        if (KIND == 1 || KIND == 2) {
            const GAS f32x4* bp = (const GAS f32x4*)((KIND == 1 ? w0 : a0) + (colt - seg * RW));
            bv[0][0] = bp[0]; bv[0][1] = bp[1]; bv[1][0] = bp[32]; bv[1][1] = bp[33];
            asm volatile("" :: "v"(bp));
        }
#pragma unroll
        for (int ai = 0; ai < 2; ++ai) {
            float rsv[4] = {1.0f, 1.0f, 1.0f, 1.0f};
            if (KIND == 0) rstdN<4>(rsv, row0 + ai * HALF, fq);
#pragma unroll
            for (int m = 0; m < 4; ++m) {
                const int row = row0 + ai * HALF + m * 16;
                const float rs = rsv[m];
#pragma unroll
                for (int bj = 0; bj < 2; ++bj) {
                    const int col = colt + bj * HALF;
                    float v[8];
#pragma unroll
                    for (int n = 0; n < 2; ++n)
#pragma unroll
                        for (int j = 0; j < 4; ++j) v[n * 4 + j] = acc[ai][bj][m][n][j] * rs;
                    if (KIND == 1) {
#pragma unroll
                        for (int e = 0; e < 8; ++e) v[e] = -0.60653066f * sigmoidf_(bv[bj][e >> 2][e & 3] + v[e]);
                    } else if (KIND == 2) {
#pragma unroll
                        for (int e = 0; e < 8; ++e) v[e] = sigmoidf_(bv[bj][e >> 2][e & 3] + v[e]);
                    }
                    u32x4 w; w.x = cvt_pk_bf16(v[0], v[1]); w.y = cvt_pk_bf16(v[2], v[3]); w.z = cvt_pk_bf16(v[4], v[5]); w.w = cvt_pk_bf16(v[6], v[7]);
                    *(GAS u32x4*)(ob + (size_t)row * ldo + col) = w;
                }
            }
        }
    }
    template <int AI, int M0> __device__ __forceinline__ void epi1_pair(const f32x4 (&acc)[2][2][4][2], int row0, int col0, int fq, const float scale, gfloat* ssq_out, int slot) const {
        const int rowa = row0 + AI * HALF + M0 * 16, rowb = rowa + 16;
        GAS f32x4* xa = (GAS f32x4*)(x + (size_t)rowa * D + col0); GAS f32x4* xb_ = (GAS f32x4*)(x + (size_t)rowb * D + col0);
        f32x4 va[2][2], vb[2][2];
#pragma unroll
        for (int bj = 0; bj < 2; ++bj)
#pragma unroll
            for (int n = 0; n < 2; ++n) { va[bj][n] = xa[bj * 32 + n * 4]; vb[bj][n] = xb_[bj * 32 + n * 4]; }
        asm volatile("" :: "v"(xa), "v"(xb_));
        GAS u32x2* oa = (GAS u32x2*)(ob + (size_t)rowa * D + col0); GAS u32x2* ob2 = (GAS u32x2*)(ob + (size_t)rowb * D + col0);
        float ssa = 0.f, ssb = 0.f;
#pragma unroll
        for (int bj = 0; bj < 2; ++bj)
#pragma unroll
            for (int n = 0; n < 2; ++n) {
                const f32x4 a = va[bj][n] + acc[AI][bj][M0][n] * scale, b = vb[bj][n] + acc[AI][bj][M0 + 1][n] * scale;
                xa[bj * 32 + n * 4] = a; xb_[bj * 32 + n * 4] = b;
                u32x2 wa; wa.x = cvt_pk_bf16(a[0], a[1]); wa.y = cvt_pk_bf16(a[2], a[3]); oa[bj * 32 + n * 4] = wa;
                u32x2 wb; wb.x = cvt_pk_bf16(b[0], b[1]); wb.y = cvt_pk_bf16(b[2], b[3]); ob2[bj * 32 + n * 4] = wb;
                ssa += (a[0] * a[0] + a[1] * a[1]) + (a[2] * a[2] + a[3] * a[3]);
                ssb += (b[0] * b[0] + b[1] * b[1]) + (b[2] * b[2] + b[3] * b[3]);
            }
        ssa = xsum_rows(ssa); ssb = xsum_rows(ssb);
        if (fq == 0) { ssq_out[(size_t)rowa * 16 + slot] = ssa; ssq_out[(size_t)rowb * 16 + slot] = ssb; }
    }
    __device__ __forceinline__ void operator()(const f32x4 (&acc)[2][2][4][2], const Unit& u, int wr, int wc, int fr, int fq, const float scale, gfloat* ssq_out) const {
        const int row0 = u.pm * BM + wr * 64 + fr;
        if (mode == 0) {
            const int col0 = u.pn * 128 + wc * 32 + 8 * fq;
#pragma unroll
            for (int ai = 0; ai < 2; ++ai) {
                float rsv[4];
                rstdN<4>(rsv, row0 + ai * HALF, fq);
#pragma unroll
                for (int m = 0; m < 4; ++m) {
                    const int row = row0 + ai * HALF + m * 16;
                    const float rs = rsv[m];
                    float hv[8];
                    const float rsl = rs * -1.44269504f, irs2 = __builtin_amdgcn_rcpf(rs * rs);
#pragma unroll
                    for (int n = 0; n < 2; ++n) {
                        const f32x4 ag = acc[ai][0][m][n], au = acc[ai][1][m][n];
                        const f32x4 pr = ag * au, tx = ag * rsl;
                        f32x4 ex;
#pragma unroll
                        for (int j = 0; j < 4; ++j) ex[j] = __builtin_amdgcn_exp2f(tx[j]);
                        const f32x4 dn = ex * irs2 + irs2;
                        f32x4 rc;
#pragma unroll
                        for (int j = 0; j < 4; ++j) rc[j] = __builtin_amdgcn_rcpf(dn[j]);
                        const f32x4 hh = pr * rc;
#pragma unroll
                        for (int j = 0; j < 4; ++j) hv[n * 4 + j] = hh[j];
                    }
                    u32x4 w; w.x = cvt_pk_bf16(hv[0], hv[1]); w.y = cvt_pk_bf16(hv[2], hv[3]); w.z = cvt_pk_bf16(hv[4], hv[5]); w.w = cvt_pk_bf16(hv[6], hv[7]);
                    *(GAS u32x4*)(ob + (size_t)row * ldo + col0) = w;
                }
            }
        } else if (mode == 1) {
            const int col0 = u.pn * BM + wc * 32 + 4 * fq;
            epi1_pair<0, 0>(acc, row0, col0, fq, scale, ssq_out, u.pn * 4 + wc); epi1_pair<0, 2>(acc, row0, col0, fq, scale, ssq_out, u.pn * 4 + wc);
            epi1_pair<1, 0>(acc, row0, col0, fq, scale, ssq_out, u.pn * 4 + wc); epi1_pair<1, 2>(acc, row0, col0, fq, scale, ssq_out, u.pn * 4 + wc);
        } else {
            if (mode == 2) epi_bf16<0>(acc, u, row0, wc, fq);
            else { const int seg = u.pn / 3; if (seg == 0) epi_bf16<1>(acc, u, row0, wc, fq); else if (seg == 1) epi_bf16<2>(acc, u, row0, wc, fq); else epi_bf16<3>(acc, u, row0, wc, fq); }
        }
    }
};

__device__ __forceinline__ void gemm_phase(LAS unsigned char* lds, const Gemm g, const StaticOrder& S, const Epi E, const float e_scale, gfloat* e_ssq_out, const int tid) {
    const int wid = __builtin_amdgcn_readfirstlane(tid >> 6), lane = tid & 63, wr = wid >> 2, wc = wid & 3, fr = lane & 15, fq = lane >> 4;
    const int K = g.K, nt = K / BK;
    unsigned voffA[2], voffB[2];
#pragma unroll
    for (int i = 0; i < 2; ++i) { int R, C; stage_rc(tid * 16 + i * 8192, R, C); const int Rb = E.perm ? ((R & ~31) + perm32(R & 31)) : R;
        voffA[i] = (unsigned)(R * K + C) * 2u; voffB[i] = (unsigned)(Rb * K + C) * 2u; }
    const size_t kstep = (size_t)(BK * 2);
    const size_t hstep = (size_t)HALF * K * 2;
    const size_t tstep = 2 * hstep;
    const unsigned ldsw = (unsigned)wid * 1024u;
    const int aoff = lds_byte(wr * 64 + fr, fq * 8), boff = lds_byte(wc * 32 + fr, fq * 8);
#define PG8_SA(b, h) (((b) * 2 + (h)) * HTB)
#define PG8_SB(b, h) ((4 + (b) * 2 + (h)) * HTB)
#define PG8_STAGE(bufoff, gbase, voff) do { _Pragma("unroll") for (int _i = 0; _i < 2; ++_i) \
        __builtin_amdgcn_global_load_lds((const unsigned*)((const char*)(gbase) + (voff)[_i]), (LAS unsigned*)(lds + (bufoff) + ldsw + _i * 8192), 16, 0, 0); } while (0)
#define PG8_LDA(dst, b, h) do { _Pragma("unroll") for (int m = 0; m < 4; ++m) _Pragma("unroll") for (int k = 0; k < 2; ++k) dst[m][k] = *(const LAS bf16x8*)(lds + PG8_SA(b, h) + aoff + m * 2048 + k * 1024); } while (0)
#define PG8_LDB(dst, b, h) do { _Pragma("unroll") for (int n = 0; n < 2; ++n) _Pragma("unroll") for (int k = 0; k < 2; ++k) dst[n][k] = *(const LAS bf16x8*)(lds + PG8_SB(b, h) + boff + n * 2048 + k * 1024); } while (0)
#define PG8_MMA(ai, bj, At, Bt) do { __builtin_amdgcn_s_setprio(1); _Pragma("unroll") for (int m = 0; m < 4; ++m) _Pragma("unroll") for (int n = 0; n < 2; ++n) _Pragma("unroll") for (int k = 0; k < 2; ++k) \
        acc[ai][bj][m][n] = __builtin_amdgcn_mfma_f32_16x16x32_bf16(Bt[n][k], At[m][k], acc[ai][bj][m][n], 0, 0, 0); __builtin_amdgcn_s_setprio(0); } while (0)
#define PG8_WAIT_V(n) asm volatile("s_waitcnt vmcnt(" #n ")" ::: "memory")
#define PG8_WAIT_L(n) asm volatile("s_waitcnt lgkmcnt(" #n ")" ::: "memory")
#define PG8_BAR __builtin_amdgcn_s_barrier()
#define PG8_SCHED __builtin_amdgcn_sched_barrier(0)
    Unit cur, nxt; int ui = 0;
    if (!S.next(0, cur)) return;
    f32x4 acc[2][2][4][2];
#pragma unroll
    for (int a = 0; a < 2; ++a)
#pragma unroll
        for (int b = 0; b < 2; ++b)
#pragma unroll
            for (int m = 0; m < 4; ++m)
#pragma unroll
                for (int n = 0; n < 2; ++n) acc[a][b][m][n] = (f32x4){0.f, 0.f, 0.f, 0.f};
    bf16x8 At[4][2], B0[2][2], B1[2][2];
    const char* cA = (const char*)g.A + (size_t)cur.pm * tstep; const char* cB = (const char*)g.Bt + (size_t)cur.pn * tstep;
    PG8_STAGE(PG8_SB(0, 0), cB, voffB); PG8_STAGE(PG8_SA(0, 0), cA, voffA); PG8_STAGE(PG8_SB(0, 1), cB + hstep, voffB); PG8_STAGE(PG8_SA(0, 1), cA + hstep, voffA);
    if (wr == 1) PG8_BAR;
    PG8_WAIT_V(4); PG8_BAR;
    PG8_STAGE(PG8_SB(1, 0), cB + kstep, voffB); PG8_STAGE(PG8_SA(1, 0), cA + kstep, voffA); PG8_STAGE(PG8_SB(1, 1), cB + hstep + kstep, voffB);
    PG8_WAIT_V(6); PG8_BAR;
    for (;;) {
        const bool has_next = S.next(ui + 1, nxt);
        const char* nA = has_next ? (const char*)g.A + (size_t)nxt.pm * tstep : cA; const char* nB = has_next ? (const char*)g.Bt + (size_t)nxt.pn * tstep : cB;
        for (int t = 0; t < nt; t += 2) {
            const bool last = (t == nt - 2);
            const char* a1 = cA + (size_t)(t + 1) * kstep;
            const char* a2 = last ? nA : cA + (size_t)(t + 2) * kstep; const char* b2 = last ? nB : cB + (size_t)(t + 2) * kstep;
            const char* a3 = a2 + kstep; const char* b3 = b2 + kstep;
            PG8_LDB(B0, 0, 0); PG8_SCHED; PG8_LDA(At, 0, 0); PG8_STAGE(PG8_SA(1, 1), a1 + hstep, voffA);
            PG8_WAIT_L(8); PG8_BAR; PG8_WAIT_L(0); PG8_MMA(0, 0, At, B0); PG8_BAR; PG8_SCHED;
            PG8_LDB(B1, 0, 1); PG8_STAGE(PG8_SB(0, 0), b2, voffB);
            PG8_BAR; PG8_WAIT_L(0); PG8_MMA(0, 1, At, B1); PG8_BAR;
            PG8_LDA(At, 0, 1); PG8_STAGE(PG8_SA(0, 0), a2, voffA);
            PG8_BAR; PG8_WAIT_L(0); PG8_MMA(1, 0, At, B0); PG8_BAR; PG8_SCHED;
            PG8_STAGE(PG8_SB(0, 1), b2 + hstep, voffB);
            PG8_WAIT_V(6); PG8_BAR; PG8_MMA(1, 1, At, B1); PG8_BAR;
            PG8_LDB(B0, 1, 0); PG8_SCHED; PG8_LDA(At, 1, 0); PG8_STAGE(PG8_SA(0, 1), a2 + hstep, voffA);
            PG8_WAIT_L(8); PG8_BAR; PG8_WAIT_L(0); PG8_MMA(0, 0, At, B0); PG8_BAR; PG8_SCHED;
            PG8_LDB(B1, 1, 1); PG8_STAGE(PG8_SB(1, 0), b3, voffB);
            PG8_BAR; PG8_WAIT_L(0); PG8_MMA(0, 1, At, B1); PG8_BAR;
            PG8_LDA(At, 1, 1); PG8_STAGE(PG8_SA(1, 0), a3, voffA);
            PG8_BAR; PG8_WAIT_L(0); PG8_MMA(1, 0, At, B0); PG8_BAR; PG8_SCHED;
            PG8_STAGE(PG8_SB(1, 1), b3 + hstep, voffB);
            PG8_WAIT_V(6); PG8_BAR; PG8_MMA(1, 1, At, B1); PG8_BAR;
        }
        E(acc, cur, wr, wc, fr, fq, e_scale, e_ssq_out);
#if EXP_DELAY
        if (E.mode == 0) { __builtin_amdgcn_s_sleep(100); __builtin_amdgcn_s_sleep(100); }
#endif
        if (!has_next) break;
#pragma unroll
        for (int a = 0; a < 2; ++a)
#pragma unroll
            for (int b = 0; b < 2; ++b)
#pragma unroll
                for (int m = 0; m < 4; ++m)
#pragma unroll
                    for (int n = 0; n < 2; ++n) acc[a][b][m][n] = (f32x4){0.f, 0.f, 0.f, 0.f};
        cur = nxt; cA = nA; cB = nB; ++ui;
    }
    PG8_WAIT_V(0);
    if (wr == 0) PG8_BAR;
    PG8_BAR;
#undef PG8_SA
#undef PG8_SB
#undef PG8_STAGE
#undef PG8_LDA
#undef PG8_LDB
#undef PG8_MMA
#undef PG8_WAIT_V
#undef PG8_WAIT_L
#undef PG8_BAR
#undef PG8_SCHED
}
}

struct Params { const float* in[33]; float* out; unsigned char* ws; int ph_lo, ph_hi; };

__device__ __forceinline__ void conv_T(const float* W, int K, int N, bf16_t* WT, const float* gain, int swi, int row_off, LAS float* scr, int gw, int NGW, int lane) {
    const int nblk = N / 32, nitems = (K / 64) * nblk;
    f32x4 tv[8];
    if (gw < nitems) {
        const int kb = gw / nblk, nb = gw % nblk;
        const float* wp = W + (size_t)(64 * kb + (lane >> 3)) * N + 32 * nb + 4 * (lane & 7);
#pragma unroll
        for (int i = 0; i < 8; ++i) tv[i] = *(const f32x4*)(wp + (size_t)(8 * i) * N);
    }
    for (int item = gw; item < nitems; item += NGW) {
        const int kb = item / nblk, nb = item % nblk, k0 = 64 * kb, n0 = 32 * nb;
#pragma unroll
        for (int i = 0; i < 8; ++i) { LAS float* d = scr + (8 * i + (lane >> 3)) * 33 + 4 * (lane & 7); d[0] = tv[i][0]; d[1] = tv[i][1]; d[2] = tv[i][2]; d[3] = tv[i][3]; }
        if (item + NGW < nitems) {
            const int it2 = item + NGW, kb2 = it2 / nblk, nb2 = it2 % nblk;
            const float* wp = W + (size_t)(64 * kb2 + (lane >> 3)) * N + 32 * nb2 + 4 * (lane & 7);
#pragma unroll
            for (int i = 0; i < 8; ++i) tv[i] = *(const f32x4*)(wp + (size_t)(8 * i) * N);
        }
        asm volatile("s_waitcnt lgkmcnt(0)" ::: "memory");
        int drow0;
        if (swi) { const int j0 = (n0 < FF) ? n0 : n0 - FF; drow0 = 256 * (j0 >> 7) + (j0 & 127) + ((n0 < FF) ? 0 : 128); } else drow0 = row_off + n0;
        const int c = lane & 7;
        float gv[8];
#pragma unroll
        for (int e = 0; e < 8; ++e) gv[e] = gain ? gain[k0 + 8 * c + e] : 1.0f;
#pragma unroll
        for (int j = 0; j < 4; ++j) { const int n = (lane >> 3) + 8 * j; const LAS float* s = scr + (8 * c) * 33 + n;
            u32x4 o; o.x = cvt_pk_bf16(s[0 * 33] * gv[0], s[1 * 33] * gv[1]); o.y = cvt_pk_bf16(s[2 * 33] * gv[2], s[3 * 33] * gv[3]);
            o.z = cvt_pk_bf16(s[4 * 33] * gv[4], s[5 * 33] * gv[5]); o.w = cvt_pk_bf16(s[6 * 33] * gv[6], s[7 * 33] * gv[7]);
            *(u32x4*)(WT + (size_t)(drow0 + n) * K + k0 + 8 * c) = o; }
        asm volatile("s_waitcnt lgkmcnt(0)" ::: "memory");
    }
}

constexpr int KS_PITCH = 72, VT_PITCH = 272;
constexpr int AT_KS = 0, AT_VT = 256 * KS_PITCH * 2, AT_RK = AT_VT + 64 * VT_PITCH * 2, AT_TB = AT_RK + 1024;
struct AttnIn { u32x4 k[4], v[4], q0, q1; };
__device__ __forceinline__ void attn_issue_kv(AttnIn& r, const bf16_t* Kp, const bf16_t* Vp, long kv_stride, bool clampk, const int tid) {
#pragma unroll
    for (int i = 0; i < 4; ++i) {
        { const int id = tid + 512 * i, key = id >> 3, ck = id & 7; const int krow = (clampk && key < 128) ? key + 128 : key;
          r.k[i] = *(const u32x4*)(Kp + (long)krow * kv_stride + ck * 8); }
        { const int id = tid + 512 * i, key = id & 255, ck = id >> 8; const int krow = (clampk && key < 128) ? key + 128 : key;
          r.v[i] = *(const u32x4*)(Vp + (long)krow * kv_stride + ck * 8); }
    }
}
__device__ __forceinline__ void attn_issue_q(AttnIn& r, const bf16_t* Qp, long q_stride, const int tid) {
    const int lane = tid & 63, w = tid >> 6, fr = lane & 15, fq = lane >> 4;
    const int qi = 16 * w + fr;
    r.q0 = *(const u32x4*)(Qp + (long)qi * q_stride + 8 * fq); r.q1 = *(const u32x4*)(Qp + (long)qi * q_stride + 32 + 8 * fq);
}
__device__ __forceinline__ void attn_issue(AttnIn& r, const bf16_t* Qp, long q_stride, const bf16_t* Kp, const bf16_t* Vp, long kv_stride, bool clampk, const int tid) {
    attn_issue_kv(r, Kp, Vp, kv_stride, clampk, tid); attn_issue_q(r, Qp, q_stride, tid);
}
template <int MODE> __device__ __forceinline__ void attn_run(LAS unsigned char* lds, AttnIn& r,
                                          int first, const float* qg1, const float* qg2, const float* rel_bias, int dil, int head,
                                          bf16_t* Op, long o_stride, float* lsep, long lse_stride, const int tid,
                                          bool has_next, const bf16_t* nQp, long nq_stride, const bf16_t* nKp, const bf16_t* nVp, long nkv_stride, bool nclamp) {
    const int lane = tid & 63, w = tid >> 6, fr = lane & 15, fq = lane >> 4;
    LAS bf16_t* Ks = (LAS bf16_t*)(lds + AT_KS); LAS bf16_t* Vt = (LAS bf16_t*)(lds + AT_VT);
    LAS float* rk = (LAS float*)(lds + AT_RK); LAS float* tb = (LAS float*)(lds + AT_TB);
    __syncthreads();
#pragma unroll
    for (int i = 0; i < 4; ++i) {
        { const int id = tid + 512 * i, key = id >> 3, ck = id & 7;
          const u32x4 kx = r.k[i];
          *(LAS u32x4*)(Ks + key * KS_PITCH + ck * 8) = kx;
          float ss = 0.f;
#pragma unroll
          for (int e = 0; e < 4; ++e) { const float a = bflo(kx[e]), b = bfhi(kx[e]); ss += a * a + b * b; }
          ss += __shfl_xor(ss, 1); ss += __shfl_xor(ss, 2); ss += __shfl_xor(ss, 4);
          if (ck == 0) rk[key] = rsqrtf(ss * (1.0f / 64.0f) + NORM_EPS); }
        { const int id = tid + 512 * i, key = id & 255, ck = id >> 8;
          const u32x4 vx = r.v[i];
#pragma unroll
          for (int e = 0; e < 4; ++e) { Vt[(ck * 8 + 2 * e) * VT_PITCH + key] = (bf16_t)(vx[e] & 0xffffu); Vt[(ck * 8 + 2 * e + 1) * VT_PITCH + key] = (bf16_t)(vx[e] >> 16); } }
    }
    if (MODE == 1 && tid < 129) {
        const int dist = tid * dil; int bucket;
        if (dist < 16) bucket = dist;
        else { const float v = logf((float)dist / 16.0f) / 4.852030263919617f * 16.0f; int lg = 16 + (int)v; bucket = lg < 31 ? lg : 31; }
        tb[tid] = rel_bias[bucket * 12 + head];
    }
    const int qi = 16 * w + fr;
    bf16x8 Qf0, Qf1; float rq;
    {
        const u32x4 q0 = r.q0, q1 = r.q1;
        float v0[8], v1[8]; float ss = 0.f;
#pragma unroll
        for (int e = 0; e < 4; ++e) { v0[2 * e] = bflo(q0[e]); v0[2 * e + 1] = bfhi(q0[e]); v1[2 * e] = bflo(q1[e]); v1[2 * e + 1] = bfhi(q1[e]); }
#pragma unroll
        for (int e = 0; e < 8; ++e) ss += v0[e] * v0[e] + v1[e] * v1[e];
        ss += __shfl_xor(ss, 16); ss += __shfl_xor(ss, 32);
        rq = rsqrtf(ss * (1.0f / 64.0f) + NORM_EPS) * 0.125f;
#pragma unroll
        for (int e = 0; e < 8; ++e) { v0[e] *= qg1[8 * fq + e] * qg2[8 * fq + e]; v1[e] *= qg1[32 + 8 * fq + e] * qg2[32 + 8 * fq + e]; }
        u32x4 a, b;
        a.x = cvt_pk_bf16(v0[0], v0[1]); a.y = cvt_pk_bf16(v0[2], v0[3]); a.z = cvt_pk_bf16(v0[4], v0[5]); a.w = cvt_pk_bf16(v0[6], v0[7]);
        b.x = cvt_pk_bf16(v1[0], v1[1]); b.y = cvt_pk_bf16(v1[2], v1[3]); b.z = cvt_pk_bf16(v1[4], v1[5]); b.w = cvt_pk_bf16(v1[6], v1[7]);
        Qf0 = __builtin_bit_cast(bf16x8, a); Qf1 = __builtin_bit_cast(bf16x8, b);
    }
    if (has_next) attn_issue_kv(r, nKp, nVp, nkv_stride, nclamp, tid);
    __syncthreads();
    constexpr int NB = (MODE == 1) ? 9 : 16, NS = (MODE == 1) ? 10 : 16;
    f32x4 s[NS];
#pragma unroll
    for (int i = 0; i < NB; ++i) {
        const int nb = (MODE == 1) ? (w + i) : i;
        const bf16x8 ka0 = *(const LAS bf16x8*)(Ks + (16 * nb + fr) * KS_PITCH + 8 * fq), ka1 = *(const LAS bf16x8*)(Ks + (16 * nb + fr) * KS_PITCH + 32 + 8 * fq);
        f32x4 z = (f32x4){0.f, 0.f, 0.f, 0.f};
        z = __builtin_amdgcn_mfma_f32_16x16x32_bf16(ka0, Qf0, z, 0, 0, 0);
        s[i] = __builtin_amdgcn_mfma_f32_16x16x32_bf16(ka1, Qf1, z, 0, 0, 0);
    }
    if (has_next) attn_issue_q(r, nQp, nq_stride, tid);
    if (MODE == 1) s[9] = (f32x4){0.f, 0.f, 0.f, 0.f};
    float mx = -3.0e38f;
#pragma unroll
    for (int i = 0; i < NB; ++i)
#pragma unroll
        for (int j = 0; j < 4; ++j) {
            const int key = 16 * ((MODE == 1) ? (w + i) : i) + 4 * fq + j;
            float lg = s[i][j] * rq * rk[key];
            if (MODE == 1) {
                const int dsub = 128 + qi - key;
                const bool valid = (dsub >= 0) && (dsub <= 128) && (first || key >= 128);
                const int di = dsub < 0 ? 0 : (dsub > 128 ? 128 : dsub);
                lg = valid ? lg + tb[di] : -1.0e30f;
            }
            s[i][j] = lg; mx = fmaxf(mx, lg);
        }
    mx = fmaxf(mx, __shfl_xor(mx, 16)); mx = fmaxf(mx, __shfl_xor(mx, 32));
    float l = 0.f;
#pragma unroll
    for (int i = 0; i < NB; ++i)
#pragma unroll
        for (int j = 0; j < 4; ++j) { const float p = __expf(s[i][j] - mx); s[i][j] = p; l += p; }
    l += __shfl_xor(l, 16); l += __shfl_xor(l, 32);
    f32x4 o[4];
#pragma unroll
    for (int nd = 0; nd < 4; ++nd) o[nd] = (f32x4){0.f, 0.f, 0.f, 0.f};
#pragma unroll
    for (int kb = 0; kb < NS / 2; ++kb) {
        u32x4 pa; pa.x = cvt_pk_bf16(s[2 * kb][0], s[2 * kb][1]); pa.y = cvt_pk_bf16(s[2 * kb][2], s[2 * kb][3]);
        pa.z = cvt_pk_bf16(s[2 * kb + 1][0], s[2 * kb + 1][1]); pa.w = cvt_pk_bf16(s[2 * kb + 1][2], s[2 * kb + 1][3]);
        const bf16x8 pf = __builtin_bit_cast(bf16x8, pa);
        int k0 = 32 * kb, k1 = 32 * kb + 16;
        if (MODE == 1) { k0 = 16 * (w + 2 * kb); const int b1 = w + 2 * kb + 1; k1 = 16 * (b1 > 15 ? 15 : b1); }
#pragma unroll
        for (int nd = 0; nd < 4; ++nd) {
            const LAS bf16_t* vp = Vt + (16 * nd + fr) * VT_PITCH + 4 * fq;
            const u32x2 v0 = *(const LAS u32x2*)(vp + k0), v1 = *(const LAS u32x2*)(vp + k1);
            u32x4 vb; vb.x = v0.x; vb.y = v0.y; vb.z = v1.x; vb.w = v1.y;
            o[nd] = __builtin_amdgcn_mfma_f32_16x16x32_bf16(pf, __builtin_bit_cast(bf16x8, vb), o[nd], 0, 0, 0);
        }
    }
    const float linv = 1.0f / l;
#pragma unroll
    for (int j = 0; j < 4; ++j) {
        const float li = __shfl(linv, 4 * fq + j);
        bf16_t* orow = Op + (long)(16 * w + 4 * fq + j) * o_stride;
#pragma unroll
        for (int nd = 0; nd < 4; ++nd) orow[16 * nd + fr] = (bf16_t)(cvt_pk_bf16(o[nd][j] * li, 0.f) & 0xffffu);
    }
    if (MODE == 1 && fq == 0) lsep[(long)qi * lse_stride] = mx + logf(l);
}
template <int MODE> __device__ __forceinline__ void attn_unit(LAS unsigned char* lds, const bf16_t* Qp, long q_stride, const bf16_t* Kp, const bf16_t* Vp, long kv_stride,
                                          int first, const float* qg1, const float* qg2, const float* rel_bias, int dil, int head,
                                          bf16_t* Op, long o_stride, float* lsep, long lse_stride, const int tid) {
    AttnIn r;
    attn_issue(r, Qp, q_stride, Kp, Vp, kv_stride, (MODE == 1) && !first, tid);
    attn_run<MODE>(lds, r, first, qg1, qg2, rel_bias, dil, head, Op, o_stride, lsep, lse_stride, tid, false, nullptr, 0, nullptr, nullptr, 0, false);
}
__device__ __forceinline__ void attn_decode_B(int u, int l, const bf16_t* qall, const bf16_t* kvb, const bf16_t* memkv,
                                              const bf16_t*& Qp, long& qs, const bf16_t*& Kp, const bf16_t*& Vp, long& kvs, bool& clampk) {
    if (u < 3072) {
        const int blk = u & 31, hh = (u >> 5) & 3, bg = u >> 7, g = bg % 3, b = bg / 3;
        const int dil = (g == 0) ? 1 : ((g == 1) ? 4 : 16), nper = 32 / dil, c = blk / nper, n = blk % nper, head = g * 4 + hh;
        const long tq0 = (long)b * SEQ + (long)(n * 128) * dil + c, tk0 = tq0 - 128L * dil;
        Qp = qall + tq0 * D + head * 64; qs = (long)dil * D; Kp = kvb + tk0 * KVW + head * 64; Vp = Kp + RW; kvs = (long)dil * KVW; clampk = (n == 0);
    } else {
        const int um = u - 3072, head = um & 3, tb = um >> 2; const long t0 = (long)tb * 128; const int b = (int)(t0 / SEQ);
        Qp = qall + t0 * D + RW + head * 64; qs = D; Kp = memkv + (size_t)(b * 256) * 2048 + l * 512 + head * 64; Vp = Kp + 256; kvs = 2048; clampk = false;
    }
}

constexpr int SC_TC = 32;
constexpr int SC_OPS = 0, SC_YB = 2 * SC_TC * 384 * 4, SC_CST = SC_YB + 16 * 512 * 4;
__device__ __forceinline__ void scan_fill(LAS float* opsd, const LAS float* cst, int ht, int tpos0, size_t tok0, int h, const bf16_t* proj, const bf16_t* lora) {
    const int htt = ht >> 4, hch = (ht & 15) * 4;
    const int tpos = tpos0 + htt; const size_t t_ = tok0 + tpos; const bool hp = tpos > 0;
    const bf16_t* p_ = proj + t_ * AIN + h * 64 + hch; const bf16_t* pq_ = p_ - (hp ? AIN : 0); const unsigned mk_ = hp ? 0xffffffffu : 0u;
    const u32x2 r_t = *(const u32x2*)p_, k_t = *(const u32x2*)(p_ + RW), v_t = *(const u32x2*)(p_ + 2 * RW);
    const u32x2 r_p = *(const u32x2*)pq_ & mk_, k_p = *(const u32x2*)(pq_ + RW) & mk_, v_p = *(const u32x2*)(pq_ + 2 * RW) & mk_;
    const bf16_t* l_ = lora + t_ * LORA_N + h * 64 + hch;
    const u32x2 pw = *(const u32x2*)l_, pa = *(const u32x2*)(l_ + RW);
    const f32x4 mur = *(const LAS f32x4*)(cst + hch), muk = *(const LAS f32x4*)(cst + 64 + hch), muv = *(const LAS f32x4*)(cst + 128 + hch),
                kks = *(const LAS f32x4*)(cst + 192 + hch), kav = *(const LAS f32x4*)(cst + 256 + hch);
    f32x4 rs, ks, vs, wv, av, kr; float ss = 0.f;
#pragma unroll
    for (int e = 0; e < 4; ++e) {
        const unsigned sh = e >> 1; const bool hi = e & 1;
        const float rt = hi ? bfhi(r_t[sh]) : bflo(r_t[sh]), rp = hi ? bfhi(r_p[sh]) : bflo(r_p[sh]);
        const float kt = hi ? bfhi(k_t[sh]) : bflo(k_t[sh]), kp = hi ? bfhi(k_p[sh]) : bflo(k_p[sh]);
        const float vt = hi ? bfhi(v_t[sh]) : bflo(v_t[sh]), vp = hi ? bfhi(v_p[sh]) : bflo(v_p[sh]);
        rs[e] = rt + mur[e] * (rp - rt); ks[e] = kt + muk[e] * (kp - kt); vs[e] = vt + muv[e] * (vp - vt);
        wv[e] = __expf(hi ? bfhi(pw[sh]) : bflo(pw[sh])); av[e] = hi ? bfhi(pa[sh]) : bflo(pa[sh]);
        kr[e] = ks[e] * kks[e]; ss += kr[e] * kr[e];
    }
    ss = allsum16(ss);
    const float inv = 1.0f / fmaxf(sqrtf(ss), 1e-12f);
    LAS float* o = opsd + htt * 384 + hch;
    f32x4 t0;
    *(LAS f32x4*)(o) = wv;
    t0 = kr * (-inv); *(LAS f32x4*)(o + 64) = t0;
    t0 = kr * inv * av; *(LAS f32x4*)(o + 128) = t0;
#pragma unroll
    for (int e = 0; e < 4; ++e) t0[e] = ks[e] * (1.0f + (av[e] - 1.0f) * kav[e]);
    *(LAS f32x4*)(o + 192) = t0;
    *(LAS f32x4*)(o + 256) = rs;
    *(LAS f32x4*)(o + 320) = vs;
}
__device__ __forceinline__ void scan_task(LAS unsigned char* lds, int b, int h, int half, const bf16_t* proj, const bf16_t* lora, bf16_t* yout,
                                          const float* mu, const float* kk_scale, const float* k_a, const int tid) {
    const int lane = tid & 63, w = tid >> 6;
    LAS float* ops = (LAS float*)(lds + SC_OPS); LAS float* ypart = (LAS float*)(lds + SC_YB); LAS float* cst = (LAS float*)(lds + SC_CST);
    __syncthreads();
    if (tid < 64) { cst[tid] = mu[h * 64 + tid]; cst[64 + tid] = mu[RW + h * 64 + tid]; cst[128 + tid] = mu[2 * RW + h * 64 + tid];
                    cst[192 + tid] = kk_scale[h * 64 + tid]; cst[256 + tid] = k_a[h * 64 + tid]; }
    const size_t tok0 = (size_t)b * SEQ;
    const int ht = tid - 256;
    __syncthreads();
    if (w >= 4) { scan_fill(ops, cst, ht, 0, tok0, h, proj, lora); scan_fill(ops + 16 * 384, cst, ht, 16, tok0, h, proj, lora); }
    const int kg = lane & 15, rA = (w & 3) * 8 + (lane >> 4), rB = rA + 4;
    const int vrowA = half * 32 + rA, vrowB = half * 32 + rB;
    f32x4 S = (f32x4){0.f, 0.f, 0.f, 0.f}, S2 = (f32x4){0.f, 0.f, 0.f, 0.f};
    __syncthreads();
    for (int c = 0; c < SEQ / SC_TC; ++c) {
        LAS float* opsb = ops + (c & 1) * (SC_TC * 384);
        LAS float* opsn = ops + ((c & 1) ^ 1) * (SC_TC * 384);
        for (int sub = 0; sub < 2; ++sub) {
            if (w < 4) {
                const LAS float* ob = opsb + (sub * 16) * 384 + kg * 4;
                const LAS float* vb = opsb + (sub * 16) * 384 + 320;
                f32x4 cw = *(const LAS f32x4*)(ob), cn = *(const LAS f32x4*)(ob + 64), cb = *(const LAS f32x4*)(ob + 128), ck = *(const LAS f32x4*)(ob + 192), cr = *(const LAS f32x4*)(ob + 256);
                float cvA = vb[vrowA], cvB = vb[vrowB];
                __builtin_amdgcn_s_setprio(3);
#pragma unroll 4
                for (int t16 = 0; t16 < 16; ++t16) {
                    const int tn = (t16 + 1) & 15;
                    const LAS float* nb_ = ob + tn * 384;
                    const f32x4 nw = *(const LAS f32x4*)(nb_), nn = *(const LAS f32x4*)(nb_ + 64), nb = *(const LAS f32x4*)(nb_ + 128), nk = *(const LAS f32x4*)(nb_ + 192), nr = *(const LAS f32x4*)(nb_ + 256);
                    const float nvA = vb[tn * 384 + vrowA], nvB = vb[tn * 384 + vrowB];
                    asm volatile("" ::: "memory");
                    f32x2 ta = S.lo * cn.lo; ta = S.hi * cn.hi + ta;
                    f32x2 tb = S2.lo * cn.lo; tb = S2.hi * cn.hi + tb;
                    float sa = ta.x + ta.y, sb = tb.x + tb.y;
                    sa = allsum16(sa); sb = allsum16(sb);
                    S = S * cw + (cb * sa + ck * cvA);
                    S2 = S2 * cw + (cb * sb + ck * cvB);
                    f32x2 ua = S.lo * cr.lo; ua = S.hi * cr.hi + ua;
                    f32x2 ub = S2.lo * cr.lo; ub = S2.hi * cr.hi + ub;
                    ypart[t16 * 512 + rA * 16 + kg] = ua.x + ua.y;
                    ypart[t16 * 512 + rB * 16 + kg] = ub.x + ub.y;
                    cw = nw; cn = nn; cb = nb; ck = nk; cr = nr; cvA = nvA; cvB = nvB;
                }
                __builtin_amdgcn_s_setprio(0);
            } else if (c + 1 < SEQ / SC_TC) {
                scan_fill(opsn + (sub * 16) * 384, cst, ht, (c + 1) * SC_TC + sub * 16, tok0, h, proj, lora);
            }
            __syncthreads();
            {
                const LAS float* yp_ = ypart + tid * 16;
                const f32x4 a = *(const LAS f32x4*)(yp_), b2 = *(const LAS f32x4*)(yp_ + 4), c2 = *(const LAS f32x4*)(yp_ + 8), d2 = *(const LAS f32x4*)(yp_ + 12);
                const float y = (((a[0] + a[1]) + (a[2] + a[3])) + ((b2[0] + b2[1]) + (b2[2] + b2[3]))) + (((c2[0] + c2[1]) + (c2[2] + c2[3])) + ((d2[0] + d2[1]) + (d2[2] + d2[3])));
                yout[(tok0 + c * SC_TC + sub * 16 + (tid >> 5)) * RW + h * 64 + half * 32 + (tid & 31)] = (bf16_t)(cvt_pk_bf16(y, 0.f) & 0xffffu);
            }
            __syncthreads();
        }
    }
}


__device__ __forceinline__ void conv_group(const __attribute__((address_space(4))) Params* PP, unsigned char* wreg, int l, int bits,
                                           LAS float* scr, int gw, int NGW, long gtid, long NGT, int lane) {
    const bool isA = l < 2; const int li = isA ? l : l - 2;
    if (bits & 1) {
        conv_T(PP->in[3] + (size_t)l * D * 2 * FF, D, 2 * FF, (bf16_t*)(wreg + W_FIN_PRE), PP->in[2] + l * D, 1, 0, scr, gw, NGW, lane);
        conv_T(PP->in[4] + (size_t)l * FF * D, FF, D, (bf16_t*)(wreg + W_FOUT_PRE), nullptr, 0, 0, scr, gw, NGW, lane);
    }
    if (bits & 2) {
        conv_T(PP->in[7] + (size_t)l * D * 2 * FF, D, 2 * FF, (bf16_t*)(wreg + W_FIN_POST), PP->in[6] + l * D, 1, 0, scr, gw, NGW, lane);
        conv_T(PP->in[8] + (size_t)l * FF * D, FF, D, (bf16_t*)(wreg + W_FOUT_POST), nullptr, 0, 0, scr, gw, NGW, lane);
    }
    if (bits & 4) {
        if (isA) conv_T(PP->in[13] + (size_t)li * D * AIN, D, AIN, (bf16_t*)(wreg + W_MIX_IN), PP->in[5] + l * D, 0, 0, scr, gw, NGW, lane);
        else conv_T(PP->in[26] + (size_t)li * D * D, D, D, (bf16_t*)(wreg + W_MIX_IN), PP->in[5] + l * D, 0, 0, scr, gw, NGW, lane);
    }
    if (bits & 8) {
        if (isA) conv_T(PP->in[25] + (size_t)li * D * D, D, D, (bf16_t*)(wreg + W_MIX_OUT), nullptr, 0, 0, scr, gw, NGW, lane);
        else conv_T(PP->in[28] + (size_t)li * 512 * D, 512, D, (bf16_t*)(wreg + W_MIX_OUT), nullptr, 0, 0, scr, gw, NGW, lane);
    }
    if ((bits & 16) && isA) {
        bf16_t* wl = (bf16_t*)(wreg + W_LORA);
        const float* wup = PP->in[16] + (size_t)li * 64 * RW; const float* aup = PP->in[18] + (size_t)li * 64 * RW; const float* gup = PP->in[19] + (size_t)li * 128 * RW;
        for (long i = gtid; i < (long)LORA_N * 256; i += NGT) {
            const int c = (int)(i >> 8), k = (int)(i & 255), seg = c / RW, cc = c - seg * RW; float v = 0.f;
            if (seg == 0) { if (k < 64) v = wup[k * RW + cc]; }
            else if (seg == 1) { if (k >= 64 && k < 128) v = aup[(k - 64) * RW + cc]; }
            else { if (k >= 128) v = gup[(k - 128) * RW + cc]; }
            wl[i] = (bf16_t)(cvt_pk_bf16(v, 0.f) & 0xffffu);
        }
    }
}

#define XB_TMO      128
#define XB_XCNT(j)  (256  + 64 * (j))
#define XB_XSUB(j)  (1280 + 64 * (j))
#define XB_XGEN(j)  (2304 + 64 * (j))
#define XB_TOP      3328
#define XB_TOPGEN   3392
#define XCD_BAR_WORDS 3456
#define XB_SPIN_CAP (1u << 18)
__device__ __forceinline__ unsigned xb_ld(unsigned* p)              { return __hip_atomic_load(p, __ATOMIC_RELAXED, __HIP_MEMORY_SCOPE_AGENT); }
__device__ __forceinline__ unsigned xb_add(unsigned* p, unsigned v) { return __hip_atomic_fetch_add(p, v, __ATOMIC_RELAXED, __HIP_MEMORY_SCOPE_AGENT); }
__device__ __forceinline__ unsigned xb_xcc_id() { return (unsigned)__builtin_amdgcn_s_getreg((3 << 11) | 20) & 0xFu; }
#define XB_SPIN(cond, bar) do { unsigned _sp = 0; while (cond) { __builtin_amdgcn_s_sleep(1); \
    if ((++_sp & 255u) == 0u) { if (xb_ld(&(bar)[XB_TMO])) break; if (_sp > XB_SPIN_CAP) { atomicAdd(&(bar)[XB_TMO], 1u); break; } } } } while (0)
struct XcdBarrier { unsigned* bar; unsigned x; volatile LAS unsigned* st; };
__device__ __forceinline__ XcdBarrier xcd_barrier_post(unsigned* bar, volatile LAS unsigned* st, const int tid) {
    XcdBarrier b; b.bar = bar; b.x = xb_xcc_id(); b.st = st;
    if (tid == 0) (void)xb_add(&bar[XB_XCNT(b.x)], 1u);
    return b;
}
__device__ __forceinline__ void xcd_barrier_complete(unsigned* bar, unsigned x, unsigned& nloc, unsigned& nx) {
    const unsigned G = gridDim.x * gridDim.y * gridDim.z;
    unsigned sum, cnt, mine, sp = 0u;
    for (;;) {
        sum = 0u; cnt = 0u; mine = 0u;
#pragma unroll
        for (unsigned j = 0; j < 16; ++j) { const unsigned c = xb_ld(&bar[XB_XCNT(j)]); sum += c; cnt += (c > 0u) ? 1u : 0u; mine = (j == x) ? c : mine; }
        if (sum == G) break;
        __builtin_amdgcn_s_sleep(1);
        if ((++sp & 255u) == 0u) { if (xb_ld(&bar[XB_TMO])) break; if (sp > XB_SPIN_CAP) { atomicAdd(&bar[XB_TMO], 1u); break; } }
    }
    nloc = mine > 0u ? mine : 1u; nx = cnt > 0u ? cnt : 1u;
}
__device__ __forceinline__ void xcd_barrier(const XcdBarrier& b, const int tid) {
    asm volatile("s_waitcnt vmcnt(0)" ::: "memory");
    __syncthreads();
    if (tid == 0) {
        unsigned* bar = b.bar;
        __builtin_amdgcn_s_waitcnt(0);
        unsigned nloc = b.st[0], nx = b.st[1];
        if (nloc == 0u) { xcd_barrier_complete(bar, b.x, nloc, nx); b.st[0] = nloc; b.st[1] = nx; }
        const unsigned old = xb_add(&bar[XB_XSUB(b.x)], 1u);
        const unsigned gen = old / nloc;
        if (old + 1u == (gen + 1u) * nloc) {
            __builtin_amdgcn_fence(__ATOMIC_RELEASE, "agent");
            asm volatile("s_waitcnt vmcnt(0)" ::: "memory");
            const unsigned og = xb_add(&bar[XB_TOP], 1u);
            const unsigned tg = og / nx;
            if (og + 1u == (tg + 1u) * nx) xb_add(&bar[XB_TOPGEN], 1u);
            else XB_SPIN(xb_ld(&bar[XB_TOPGEN]) == tg, bar);
            __builtin_amdgcn_fence(__ATOMIC_ACQUIRE, "agent");
            xb_add(&bar[XB_XGEN(b.x)], 1u);
            asm volatile("s_waitcnt vmcnt(0)" ::: "memory");
        } else {
            XB_SPIN(xb_ld(&bar[XB_XGEN(b.x)]) == gen, bar);
            __builtin_amdgcn_fence(__ATOMIC_ACQUIRE, "agent");
            asm volatile("s_waitcnt vmcnt(0)" ::: "memory");
        }
    }
    __syncthreads();
}

__global__ void __launch_bounds__(512, 2) fwd_kernel(Params P) {
    extern __shared__ __attribute__((aligned(16))) unsigned char lds_raw[];
    LAS unsigned char* lds = (LAS unsigned char*)lds_raw;
#if MK_SINGLE
    volatile LAS unsigned* misc = (volatile LAS unsigned*)(lds + MISC_OFF);
    if (threadIdx.x < 2) misc[threadIdx.x] = 0u;
    __syncthreads();
    (void)xcd_barrier_post((unsigned*)(P.ws + WS_BAR), misc, (int)threadIdx.x);
#endif
    const int wave_s = __builtin_amdgcn_readfirstlane((int)threadIdx.x >> 6);
    for (int it = P.ph_lo * 2; it < P.ph_hi * 2; ++it) {
        const int ph = it >> 1;
        if ((it & 1) && !((DUPMASK >> (ph % 12)) & 1)) continue;
        int tid = (wave_s << 6) | (int)__builtin_amdgcn_mbcnt_hi(~0u, __builtin_amdgcn_mbcnt_lo(~0u, 0u)); asm volatile("" : "+v"(tid));
        int bx = blockIdx.x; asm volatile("" : "+s"(bx));
        int G = gridDim.x; asm volatile("" : "+s"(G));
        const __attribute__((address_space(4))) Params* PP = (const __attribute__((address_space(4))) Params*)__builtin_amdgcn_kernarg_segment_ptr(); asm volatile("" : "+s"(PP));
        unsigned char* ws = PP->ws; float* X = PP->out;
#define lane (tid & 63)
#define wave (tid >> 6)
#define gw (bx * 8 + (tid >> 6))
#define NGW (G * 8)
#define gtid ((long)bx * 512 + tid)
#define NGT ((long)G * 512)
        float* ssq = (float*)(ws + WS_SSQ); float* memssq = (float*)(ws + WS_MEMSSQ); float* lse = (float*)(ws + WS_LSE);
        bf16_t* memb = (bf16_t*)(ws + WS_MEMB); bf16_t* memkv = (bf16_t*)(ws + WS_MEMKV);
        bf16_t* xb = (bf16_t*)(ws + WS_XB); bf16_t* yscan = xb; bf16_t* aprep = (bf16_t*)(ws + WS_XB + 48 * MiB);
        bf16_t* hbuf = (bf16_t*)(ws + WS_H); bf16_t* proj = hbuf; bf16_t* qall = hbuf; bf16_t* catb = (bf16_t*)(ws + WS_H + 64 * MiB);
        bf16_t* lora = (bf16_t*)(ws + WS_LORA); bf16_t* kvb = lora; bf16_t* og = (bf16_t*)(ws + WS_LORA + 96 * MiB); bf16_t* wmemkv = lora;
        bf16_t* cat = (bf16_t*)(ws + WS_CAT);
        unsigned char* wreg = ws + WS_W;
#define scr ((LAS float*)(lds + (tid >> 6) * 16384))
        const int l = ph / 12, p = ph % 12;
        const bool isA = l < 2; const int li = isA ? l : l - 2;
        const bool empty = (!isA && (p == 6 || p == 7)) || (p == 11 && l != 1) || (p == 0 && l != 0);
        if (empty) continue;
        if (p == 0) {
            if (l == 0) {
                for (int m = gw; m < T; m += NGW) {
                    const f32x4* xr = (const f32x4*)(PP->in[0] + (size_t)m * D) + lane; float s = 0.f;
#pragma unroll
                    for (int j = 0; j < 4; ++j) { const f32x4 v = xr[64 * j]; s += (v[0] * v[0] + v[1] * v[1]) + (v[2] * v[2] + v[3] * v[3]);
                        *((f32x4*)(X + (size_t)m * D) + lane + 64 * j) = v;
                        u32x2 o; o.x = cvt_pk_bf16(v[0], v[1]); o.y = cvt_pk_bf16(v[2], v[3]); *((u32x2*)(xb + (size_t)m * D) + lane + 64 * j) = o; }
#pragma unroll
                    for (int o = 1; o < 64; o <<= 1) s += __shfl_xor(s, o);
                    if (lane < 16) ssq[(size_t)m * 16 + lane] = (lane == 0) ? s : 0.f;
                }
                for (int m = gw; m < 2048; m += NGW) {
                    const f32x4* xr = (const f32x4*)(PP->in[1] + (size_t)m * D) + lane; float s = 0.f;
#pragma unroll
                    for (int j = 0; j < 4; ++j) { const f32x4 v = xr[64 * j]; s += (v[0] * v[0] + v[1] * v[1]) + (v[2] * v[2] + v[3] * v[3]);
                        u32x2 o; o.x = cvt_pk_bf16(v[0], v[1]); o.y = cvt_pk_bf16(v[2], v[3]); *((u32x2*)(memb + (size_t)m * D) + lane + 64 * j) = o; }
#pragma unroll
                    for (int o = 1; o < 64; o <<= 1) s += __shfl_xor(s, o);
                    if (lane < 16) memssq[(size_t)m * 16 + lane] = (lane == 0) ? s : 0.f;
                }
                for (int q = 0; q < 4; ++q)
                    conv_T(PP->in[10] + (size_t)q * D * 512, D, 512, wmemkv, PP->in[9] + q * D, 0, q * 512, scr, gw, NGW, lane);
            }
            conv_group(PP, wreg, 0, 1 | 4 | 8 | 16, scr, gw, NGW, gtid, NGT, lane);
        } else if (p == 1 || p == 2 || p == 3 || p == 5 || p == 8 || p == 9 || p == 10 || p == 11) {
            if (p == 5 && !isA) {
                if (l == 2) { conv_group(PP, wreg, 2, 2, scr, gw, NGW, gtid, NGT, lane);
                              conv_group(PP, wreg, 3, 1 | 4, scr, gw, NGW, gtid, NGT, lane); }
                if (l == 3) conv_group(PP, wreg, 3, 2, scr, gw, NGW, gtid, NGT, lane);
                for (long i0 = gtid; i0 < (long)T * 64; i0 += 4 * NGT) {
                    float l0[4], l1[4], l2[4]; u32x2 a[4], b[4], c[4];
#pragma unroll
                    for (int u = 0; u < 4; ++u) { const long i = i0 + u * NGT; const long t = i >> 6; const int hh = (int)(i >> 4) & 3, d = ((int)i & 15) * 4;
                        l0[u] = lse[t * 12 + hh]; l1[u] = lse[t * 12 + 4 + hh]; l2[u] = lse[t * 12 + 8 + hh];
                        a[u] = *(const u32x2*)(og + t * RW + hh * 64 + d); b[u] = *(const u32x2*)(og + t * RW + (4 + hh) * 64 + d); c[u] = *(const u32x2*)(og + t * RW + (8 + hh) * 64 + d); }
#pragma unroll
                    for (int u = 0; u < 4; ++u) { const long i = i0 + u * NGT; const long t = i >> 6; const int hh = (int)(i >> 4) & 3, d = ((int)i & 15) * 4;
                        const float mx = fmaxf(l0[u], fmaxf(l1[u], l2[u])); float w0 = __expf(l0[u] - mx), w1 = __expf(l1[u] - mx), w2 = __expf(l2[u] - mx);
                        const float inv = 1.0f / (w0 + w1 + w2); w0 *= inv; w1 *= inv; w2 *= inv;
                        u32x2 o; o.x = cvt_pk_bf16(w0 * bflo(a[u].x) + w1 * bflo(b[u].x) + w2 * bflo(c[u].x), w0 * bfhi(a[u].x) + w1 * bfhi(b[u].x) + w2 * bfhi(c[u].x));
                        o.y = cvt_pk_bf16(w0 * bflo(a[u].y) + w1 * bflo(b[u].y) + w2 * bflo(c[u].y), w0 * bfhi(a[u].y) + w1 * bfhi(b[u].y) + w2 * bfhi(c[u].y));
                        *(u32x2*)(catb + t * 512 + hh * 64 + d) = o; }
                }
            } else {
                if (p == 9 && l == 1)
                    conv_T(PP->in[30], D, KVW, (bf16_t*)(wreg + W_MIX_IN), PP->in[29], 0, 0, scr, gw, NGW, lane);
                if (p == 9 && l == 0) conv_group(PP, wreg, 1, 8, scr, gw, NGW, gtid, NGT, lane);
                if (p == 9 && l == 2) conv_group(PP, wreg, 3, 8, scr, gw, NGW, gtid, NGT, lane);
                if (p == 2 && l == 2) conv_group(PP, wreg, 2, 4 | 8, scr, gw, NGW, gtid, NGT, lane);
                const int nrep = (p == 3 && l == 0 && bx >= G / 2) ? 2 : 1;
                for (int rep = 0; rep < nrep; ++rep) {
                    const bf16_t* gA = xb; const bf16_t* gB = (const bf16_t*)wreg; int gM = T, gN = D, gK = D;
                    int e_mode = 2, e_perm = 1, e_ldo = 0; const float* e_ssq_in = nullptr; bf16_t* e_ob = nullptr; float e_scale = 0.f; float* e_ssq_out = nullptr;
                    const float* e_w0 = nullptr; const float* e_a0 = nullptr;
                    if (rep == 1) { gA = memb; gB = wmemkv; gM = 2048; gN = 2048; gK = D; e_ssq_in = memssq; e_ob = memkv; e_ldo = 2048; }
                    else if (p == 1) { gB = (bf16_t*)(wreg + W_FIN_PRE); gN = 2 * FF; e_mode = 0; e_ssq_in = ssq + 0; e_ob = hbuf; e_ldo = FF; }
                    else if (p == 2) { gA = hbuf; gB = (bf16_t*)(wreg + W_FOUT_PRE); gK = FF; e_mode = 1; e_perm = 0; e_scale = 0.5f; e_ob = xb; e_ssq_out = ssq + 0; }
                    else if (p == 3) { gB = (bf16_t*)(wreg + W_MIX_IN); gN = isA ? AIN : D; e_ssq_in = ssq + 0; e_ob = hbuf; e_ldo = isA ? AIN : D; }
                    else if (p == 5) { gA = aprep; gB = (bf16_t*)(wreg + W_LORA); gN = LORA_N; gK = 256; e_mode = 3; e_ob = lora; e_ldo = LORA_N; e_w0 = PP->in[15] + li * RW; e_a0 = PP->in[17] + li * RW; }
                    else if (p == 8) { gA = isA ? cat : catb; gB = (bf16_t*)(wreg + W_MIX_OUT); gK = isA ? D : 512; e_mode = 1; e_perm = 0; e_scale = 1.0f; e_ob = xb; e_ssq_out = ssq + 0; }
                    else if (p == 9) { gB = (bf16_t*)(wreg + W_FIN_POST); gN = 2 * FF; e_mode = 0; e_ssq_in = ssq + 0; e_ob = hbuf; e_ldo = FF; }
                    else if (p == 10) { gA = hbuf; gB = (bf16_t*)(wreg + W_FOUT_POST); gK = FF; e_mode = 1; e_perm = 0; e_scale = 0.5f; e_ob = xb; e_ssq_out = ssq + 0; }
                    else { gB = (bf16_t*)(wreg + W_MIX_IN); gN = KVW; e_ssq_in = ssq + 0; e_ob = kvb; e_ldo = KVW; }
                    const pg8::Gemm g{gA, gB, gM, gN, gK};
                    const pg8::Epi E{e_mode, e_perm, (const gfloat*)e_ssq_in, (gbf16*)e_ob, e_ldo, (gfloat*)X, (const gfloat*)e_w0, (const gfloat*)e_a0};
                    if (p == 9 && l == 1) { __threadfence(); }
                    pg8::StaticOrder S; if (rep == 1) S.init(g.M, g.N, G / 2, bx - G / 2); else S.init(g.M, g.N, G, bx);
                    __syncthreads();
                    int tg = tid; asm volatile("" : "+v"(tg));
                    const float e_scale_s = __int_as_float(__builtin_amdgcn_readfirstlane(__float_as_int(e_scale)));
                    pg8::gemm_phase(lds, g, S, E, e_scale_s, (gfloat*)e_ssq_out, tg);
                    __syncthreads();
                }
            }
        } else if (p == 4) {
            if (isA) {
                const float* mu = PP->in[14] + (size_t)li * 2560 + 2304;
                const int j = ((int)gtid & 63) * 4;
                const f32x4 m4 = *(const f32x4*)(mu + j);
                for (long i0 = gtid; i0 < (long)T * 64; i0 += 4 * NGT) {
                    u32x2 a[4], b[4];
#pragma unroll
                    for (int u = 0; u < 4; ++u) { const long t = (i0 + u * NGT) >> 6;
                        a[u] = *(const u32x2*)(proj + t * AIN + 2304 + j);
                        const bool hp = (t & (SEQ - 1)) != 0; const unsigned mk = hp ? 0xffffffffu : 0u; b[u] = *(const u32x2*)(proj + (t - (hp ? 1 : 0)) * AIN + 2304 + j) & mk; }
#pragma unroll
                    for (int u = 0; u < 4; ++u) { const long t = (i0 + u * NGT) >> 6;
                        float v[4]; v[0] = bflo(a[u].x) + m4[0] * (bflo(b[u].x) - bflo(a[u].x)); v[1] = bfhi(a[u].x) + m4[1] * (bfhi(b[u].x) - bfhi(a[u].x));
                        v[2] = bflo(a[u].y) + m4[2] * (bflo(b[u].y) - bflo(a[u].y)); v[3] = bfhi(a[u].y) + m4[3] * (bfhi(b[u].y) - bfhi(a[u].y));
                        if (j < 64) {
#pragma unroll
                            for (int e = 0; e < 4; ++e) v[e] = 1.0f - 2.0f * __builtin_amdgcn_rcpf(1.0f + __expf(2.0f * v[e]));
                        } else if (j >= 128) {
#pragma unroll
                            for (int e = 0; e < 4; ++e) v[e] = sigmoidf_(v[e]);
                        }
                        u32x2 o; o.x = cvt_pk_bf16(v[0], v[1]); o.y = cvt_pk_bf16(v[2], v[3]);
                        *(u32x2*)(aprep + t * 256 + j) = o; }
                }
            }
            if (!isA) {
                AttnIn r;
                { const bf16_t* Qp; const bf16_t* Kp; const bf16_t* Vp; long qs, kvs; bool ck;
                  attn_decode_B(bx, l, qall, kvb, memkv, Qp, qs, Kp, Vp, kvs, ck); attn_issue(r, Qp, qs, Kp, Vp, kvs, ck, tid); }
                for (int u = bx; u < 4096; u += G) {
                    int tidu = tid; asm volatile("" : "+v"(tidu));
                    const int un = u + G; const bool hn = un < 4096;
                    const bf16_t* nQ = qall; const bf16_t* nK = kvb; const bf16_t* nV = kvb; long nqs = 0, nkvs = 0; bool nck = false;
                    if (hn) attn_decode_B(un, l, qall, kvb, memkv, nQ, nqs, nK, nV, nkvs, nck);
                    if (u < 3072) {
                        const int blk = u & 31, hh = (u >> 5) & 3, bg = u >> 7, g = bg % 3, b = bg / 3;
                        const int dil = (g == 0) ? 1 : ((g == 1) ? 4 : 16), nper = 32 / dil, c = blk / nper, n = blk % nper, head = g * 4 + hh;
                        const long tq0 = (long)b * SEQ + (long)(n * 128) * dil + c;
                        attn_run<1>(lds, r, n > 0 ? 1 : 0, PP->in[27] + li * 64, PP->in[31], PP->in[32], dil, head, og + tq0 * RW + head * 64, (long)dil * RW, lse + tq0 * 12 + head, (long)dil * 12, tidu,
                                    hn, nQ, nqs, nK, nV, nkvs, nck);
                    } else {
                        const int um = u - 3072, head = um & 3, tb = um >> 2; const long t0 = (long)tb * 128;
                        attn_run<0>(lds, r, 1, PP->in[11] + l * 64, PP->in[12] + l * 64, nullptr, 1, 0, catb + t0 * 512 + 256 + head * 64, 512, nullptr, 0, tidu,
                                    hn, nQ, nqs, nK, nV, nkvs, nck);
                    }
                }
            }
        } else if (p == 6) {
            if (bx >= 192) {
                const int sub = bx - 192, nsub = G - 192;
                for (int um = sub; um < 1024; um += nsub) {
                    int tidu = tid; asm volatile("" : "+v"(tidu));
                    const int head = um & 3, tb = um >> 2; const long t0 = (long)tb * 128; const int b = (int)(t0 / SEQ);
                    attn_unit<0>(lds, proj + t0 * AIN + 2560 + head * 64, AIN, memkv + (size_t)(b * 256) * 2048 + l * 512 + head * 64, memkv + (size_t)(b * 256) * 2048 + l * 512 + 256 + head * 64, 2048,
                                 1, PP->in[11] + l * 64, PP->in[12] + l * 64, nullptr, 1, 0, cat + t0 * D + RW + head * 64, D, nullptr, 0, tidu);
                }
                __syncthreads();
                const int gw2 = sub * 8 + wave, NGW2 = nsub * 8; const long gtid2 = (long)sub * 512 + tid, NGT2 = (long)nsub * 512;
                conv_group(PP, wreg, l, 2, scr, gw2, NGW2, gtid2, NGT2, lane);
                conv_group(PP, wreg, l + 1, (l == 0) ? (1 | 4 | 16) : 1, scr, gw2, NGW2, gtid2, NGT2, lane);
            }
            for (int task = bx; task < 192; task += G) {
                const int half = (task >> 3) & 1, bh = (task & 7) + 8 * (task >> 4);
                const int b = bh / 12, h = bh % 12;
                scan_task(lds, b, h, half, proj, lora, yscan, PP->in[14] + (size_t)li * 2560, PP->in[20] + li * RW, PP->in[21] + li * RW, tid);
            }
        } else if (p == 7) {
            const float* mu = PP->in[14] + (size_t)li * 2560; const float* k_a = PP->in[21] + li * RW; const float* r_k = PP->in[22] + li * RW;
            const float* lng = PP->in[23] + li * RW; const float* lnb = PP->in[24] + li * RW;
            const int q3 = gw % 3, tstep = NGW / 3; const int col = q3 * 256 + lane * 4;
            const f32x4 mr = *(const f32x4*)(mu + col), mk = *(const f32x4*)(mu + RW + col), mv = *(const f32x4*)(mu + 2 * RW + col);
            const f32x4 ka = *(const f32x4*)(k_a + col), rk4 = *(const f32x4*)(r_k + col), g4 = *(const f32x4*)(lng + col), b4 = *(const f32x4*)(lnb + col);
#define POST_LOAD(T_, S) \
                const bool hp##S = ((T_) & (SEQ - 1)) != 0; \
                const u32x2 yv##S = *(const u32x2*)(yscan + (T_) * RW + col); \
                const bf16_t* pp##S = proj + (T_) * AIN + col; \
                const u32x2 rt##S = *(const u32x2*)pp##S, kt##S = *(const u32x2*)(pp##S + RW), vt##S = *(const u32x2*)(pp##S + 2 * RW); \
                const bf16_t* pq##S = pp##S - (hp##S ? AIN : 0); const unsigned msk##S = hp##S ? 0xffffffffu : 0u; \
                const u32x2 rp##S = *(const u32x2*)pq##S & msk##S, kp##S = *(const u32x2*)(pq##S + RW) & msk##S, vp##S = *(const u32x2*)(pq##S + 2 * RW) & msk##S; \
                const u32x2 av##S = *(const u32x2*)(lora + (T_) * LORA_N + RW + col), gv##S = *(const u32x2*)(lora + (T_) * LORA_N + 2 * RW + col);
#define POST_COMP(T_, S) { \
                float y[4] = {bflo(yv##S.x), bfhi(yv##S.x), bflo(yv##S.y), bfhi(yv##S.y)}; \
                const float r0[4] = {bflo(rt##S.x), bfhi(rt##S.x), bflo(rt##S.y), bfhi(rt##S.y)}, r1[4] = {bflo(rp##S.x), bfhi(rp##S.x), bflo(rp##S.y), bfhi(rp##S.y)}; \
                const float k0[4] = {bflo(kt##S.x), bfhi(kt##S.x), bflo(kt##S.y), bfhi(kt##S.y)}, k1[4] = {bflo(kp##S.x), bfhi(kp##S.x), bflo(kp##S.y), bfhi(kp##S.y)}; \
                const float v0[4] = {bflo(vt##S.x), bfhi(vt##S.x), bflo(vt##S.y), bfhi(vt##S.y)}, v1[4] = {bflo(vp##S.x), bfhi(vp##S.x), bflo(vp##S.y), bfhi(vp##S.y)}; \
                const float aa[4] = {bflo(av##S.x), bfhi(av##S.x), bflo(av##S.y), bfhi(av##S.y)}, gg[4] = {bflo(gv##S.x), bfhi(gv##S.x), bflo(gv##S.y), bfhi(gv##S.y)}; \
                float mean = allsum16((y[0] + y[1]) + (y[2] + y[3])) * (1.0f / 64.0f); \
                float var = 0.f, sb = 0.f, vs[4]; \
                _Pragma("unroll") for (int e = 0; e < 4; ++e) { y[e] -= mean; var += y[e] * y[e]; \
                    const float rs = r0[e] + mr[e] * (r1[e] - r0[e]), ks = k0[e] + mk[e] * (k1[e] - k0[e]); vs[e] = v0[e] + mv[e] * (v1[e] - v0[e]); \
                    sb += rs * ks * (1.0f + (aa[e] - 1.0f) * ka[e]) * rk4[e]; } \
                var = allsum16(var) * (1.0f / 64.0f); sb = allsum16(sb); \
                const float rstd = rsqrtf(var + 64e-5f); \
                float o[4]; \
                _Pragma("unroll") for (int e = 0; e < 4; ++e) o[e] = (y[e] * rstd * g4[e] + b4[e] + sb * vs[e]) * gg[e]; \
                u32x2 ow; ow.x = cvt_pk_bf16(o[0], o[1]); ow.y = cvt_pk_bf16(o[2], o[3]); \
                *(u32x2*)(cat + (T_) * D + col) = ow; }
            for (long t = (gw < 3 * tstep) ? gw / 3 : T; t < T; t += 2 * tstep) {
                const long tB = t + tstep; const bool hasB = tB < T; const long tBc = hasB ? tB : t;
                POST_LOAD(t, A)
                POST_LOAD(tBc, B)
                POST_COMP(t, A)
                if (hasB) POST_COMP(tB, B)
            }
#undef POST_LOAD
#undef POST_COMP
        }
#if MK_SINGLE
        if (it + 2 < P.ph_hi * 2) { if (it == 0) cg::this_grid().sync(); else { XcdBarrier xb_; xb_.bar = (unsigned*)(ws + WS_BAR); xb_.x = xb_xcc_id(); xb_.st = (volatile LAS unsigned*)(lds + MISC_OFF); xcd_barrier(xb_, tid); } }
#endif
    }
}

#undef lane
#undef wave
#undef gw
#undef NGW
#undef gtid
#undef NGT
#undef scr
extern "C" void kernel_launch(void* const* d_in, const int* in_sizes, int n_in, void* d_out, int out_size, void* d_ws, size_t ws_size, hipStream_t stream) {
    static int ready = 0;
    if (!ready) {
        if (n_in != 33 || out_size != T * D || ws_size < WS_END) { fprintf(stderr, "kernel_launch: unexpected shapes (n_in %d out %d ws %zu)\n", n_in, out_size, ws_size); ready = -1; return; }
        if (hipFuncSetAttribute((const void*)fwd_kernel, hipFuncAttributeMaxDynamicSharedMemorySize, LDS_BYTES) != hipSuccess) { fprintf(stderr, "kernel_launch: hipFuncSetAttribute failed\n"); ready = -1; return; }
        int per_cu = 0;
        hipOccupancyMaxActiveBlocksPerMultiprocessor(&per_cu, (const void*)fwd_kernel, 512, LDS_BYTES);
        if (per_cu < 1) fprintf(stderr, "kernel_launch: occupancy query says %d blocks per CU\n", per_cu);
        (void)hipGetLastError();
        ready = 1;
    }
    if (ready < 0) return;
    Params p{};
    for (int i = 0; i < 33; ++i) p.in[i] = (const float*)d_in[i];
    p.out = (float*)d_out; p.ws = (unsigned char*)d_ws;
    const int grid = 256;
#if MK_SINGLE
    hipMemsetAsync((char*)d_ws + WS_BAR, 0, 16384, stream);
    p.ph_lo = 0; p.ph_hi = 48;
    void* args[] = {&p};
    hipError_t e = hipLaunchCooperativeKernel((const void*)fwd_kernel, dim3(grid), dim3(512), args, LDS_BYTES, stream);
    if (e != hipSuccess) fprintf(stderr, "cooperative launch failed: %s\n", hipGetErrorString(e));
#else
    for (int ph = 0; ph < 48; ++ph) {
        const int l = ph / 12, q = ph % 12; const bool isA = l < 2;
        if ((!isA && (q == 6 || q == 7)) || (q == 11 && l != 1) || (q == 0 && l != 0)) continue;
        p.ph_lo = ph; p.ph_hi = ph + 1;
        hipLaunchKernelGGL(fwd_kernel, dim3(grid), dim3(512), LDS_BYTES, stream, p);
    }
#endif
}
```
